# Optimizing an MI355X kernel written in HIP

```python
import math
import jax, jax.numpy as jnp
from jax import lax
import numpy as np

D_MODEL = 1024
BATCH = 2
SEQ = 8192
DEPTH = 1
DEC_BATCH = 8
DEC_SEQ = 2048
PAST_LEN = 128

GRID_W = 64
PLE_DIM = 256
D_FF = 4 * D_MODEL
NORM_EPS = 1e-6
DN_QK_HEADS = 4
DN_V_HEADS = 8
DN_DK = 128
DN_DV = 128
DN_CHUNK = 64
DN_CONV = 5
DN_QKV_W = 2 * DN_QK_HEADS * DN_DK + DN_V_HEADS * DN_DV
DN_Z_W = DN_V_HEADS * DN_DV
ATT_HEADS = 8
ATT_KV_HEADS = 2
ATT_GROUP = ATT_HEADS // ATT_KV_HEADS
HEAD_DIM = 128
Q_BLOCK = 128
ROPE_THETA = 10000.0
IN_SPLITS = (DN_QKV_W, DN_Z_W, 2 * DN_V_HEADS, 2 * DN_V_HEADS,
             ATT_HEADS * HEAD_DIM, ATT_KV_HEADS * HEAD_DIM, ATT_KV_HEADS * HEAD_DIM,
             D_MODEL, D_MODEL)
IN_COLS = sum(IN_SPLITS)

kernel_name = "hybrid_gdn_axial_gqa_encoder"


def rms_norm(x, gain):
    xf = x.astype(jnp.float32)
    y = xf * lax.rsqrt(jnp.mean(xf * xf, axis=-1, keepdims=True) + NORM_EPS)
    return (y * gain.astype(jnp.float32)).astype(x.dtype)


def l2_norm(x):
    xf = x.astype(jnp.float32)
    return xf * lax.rsqrt(jnp.sum(xf * xf, axis=-1, keepdims=True) + NORM_EPS)


def split_cols(t, sizes):
    out, start = [], 0
    for s in sizes:
        out.append(t[..., start:start + s])
        start += s
    return out


def centred_depthwise_conv(x, w):
    pad = w.shape[0] // 2
    return lax.conv_general_dilated(
        x, w[:, None, :].astype(x.dtype), window_strides=(1,), padding=[(pad, pad)],
        dimension_numbers=("NWC", "WIO", "NWC"), feature_group_count=x.shape[-1])


def gated_delta_chunked(q, k, v, g, beta):
    bsz, n, h, dk = q.shape
    dv = v.shape[-1]
    nc = n // DN_CHUNK

    def chunks(t):
        return t.reshape(bsz, nc, DN_CHUNK, h, -1).transpose(0, 3, 1, 2, 4)

    q = chunks(q) * (dk ** -0.5)
    k = chunks(k)
    v = chunks(v)
    g = g.reshape(bsz, nc, DN_CHUNK, h).transpose(0, 3, 1, 2)
    beta = beta.reshape(bsz, nc, DN_CHUNK, h).transpose(0, 3, 1, 2)
    gc = jnp.cumsum(g, axis=-1)
    idx = jnp.arange(DN_CHUNK)
    incl = idx[:, None] >= idx[None, :]
    strict = idx[:, None] > idx[None, :]
    diff = gc[..., :, None] - gc[..., None, :]
    decay = jnp.where(incl, jnp.exp(jnp.where(incl, diff, 0.0)), 0.0)
    kb = k * beta[..., None]
    a = jnp.where(strict, jnp.einsum("bhncd,bhnsd->bhncs", kb, k) * decay, 0.0)
    rhs = jnp.concatenate([v * beta[..., None], kb * jnp.exp(gc)[..., None]], axis=-1)
    sol = lax.linalg.triangular_solve(a + jnp.eye(DN_CHUNK, dtype=a.dtype), rhs,
                                      left_side=True, lower=True, unit_diagonal=True)
    u, w = sol[..., :dv], sol[..., dv:]
    aqk = jnp.einsum("bhncd,bhnsd->bhncs", q, k) * decay
    gl = gc[..., -1]
    kd = k * jnp.exp(gl[..., None] - gc)[..., None]
    qd = q * jnp.exp(gc)[..., None]
    xs = tuple(jnp.moveaxis(t, 2, 0) for t in (qd, aqk, u, w, kd, gl))

    def step(state, inp):
        qd_i, aqk_i, u_i, w_i, kd_i, gl_i = inp
        v_new = u_i - jnp.einsum("bhck,bhkv->bhcv", w_i, state)
        o = jnp.einsum("bhck,bhkv->bhcv", qd_i, state) + jnp.einsum("bhcs,bhsv->bhcv", aqk_i, v_new)
        state = state * jnp.exp(gl_i)[..., None, None] + jnp.einsum("bhck,bhcv->bhkv", kd_i, v_new)
        return state, o

    s0 = jnp.zeros((bsz, h, dk, dv), jnp.float32)
    _, o = lax.scan(step, s0, xs)
    return o.transpose(1, 0, 3, 2, 4).reshape(bsz, n, h, dv)


def axial_rope_angles(n):
    rows = n // GRID_W
    r = jnp.repeat(jnp.arange(rows), GRID_W).astype(jnp.float32)
    c = jnp.tile(jnp.arange(GRID_W), rows).astype(jnp.float32)
    half = HEAD_DIM // 2
    inv = jnp.power(jnp.float32(ROPE_THETA), -jnp.arange(0, half, 2, dtype=jnp.float32) / half)
    return jnp.stack([r[:, None] * inv, c[:, None] * inv], axis=1)


def apply_axial_rope(x, ang):
    bsz, n, h, d = x.shape
    xr = x.astype(jnp.float32).reshape(bsz, n, h, 2, 2, d // 4)
    cos = jnp.cos(ang)[:, None]
    sin = jnp.sin(ang)[:, None]
    x1, x2 = xr[..., 0, :], xr[..., 1, :]
    out = jnp.stack([x1 * cos - x2 * sin, x2 * cos + x1 * sin], axis=-2)
    return out.reshape(bsz, n, h, d).astype(x.dtype)


def block_attention(q, k, v):
    bsz, n, _, d = q.shape
    nb = n // Q_BLOCK
    qb = q.reshape(bsz, nb, Q_BLOCK, ATT_KV_HEADS, ATT_GROUP, d).transpose(1, 0, 2, 3, 4, 5)
    scale = d ** -0.5

    def one_block(qblk):
        s = jnp.einsum("bqhgd,bkhd->bhgqk", qblk, k).astype(jnp.float32) * scale
        p = jax.nn.softmax(s, axis=-1)
        return jnp.einsum("bhgqk,bkhd->bqhgd", p.astype(v.dtype), v)

    o = lax.map(one_block, qb)
    return o.transpose(1, 0, 2, 3, 4, 5).reshape(bsz, n, ATT_HEADS * d)


def encoder_layer(h, pe, norm_mix, w_in, dn_conv_w, dn_a_log, dn_dt_bias, dn_out_norm,
                  w_dn_branch, q_norm, k_norm, w_attn_branch, w_o, norm_mlp, w_up, w_down,
                  norm_ple, w_ple_gate, w_ple):
    bsz, n, _ = h.shape
    u = rms_norm(h, norm_mix)
    proj = u @ w_in
    dn_qkv, dn_z, dn_b, dn_a, at_q, at_k, at_v, gate_dn, gate_at = split_cols(proj, IN_SPLITS)

    qkv = jax.nn.silu(centred_depthwise_conv(dn_qkv, dn_conv_w))
    dq, dk_, dv_ = split_cols(qkv, (DN_QK_HEADS * DN_DK, DN_QK_HEADS * DN_DK, DN_V_HEADS * DN_DV))
    rep = DN_V_HEADS // DN_QK_HEADS
    dq = jnp.repeat(l2_norm(dq.reshape(bsz, n, DN_QK_HEADS, DN_DK)), rep, axis=2)
    dk_ = jnp.repeat(l2_norm(dk_.reshape(bsz, n, DN_QK_HEADS, DN_DK)), rep, axis=2)
    dv_ = dv_.reshape(bsz, n, DN_V_HEADS, DN_DV).astype(jnp.float32)
    beta = jax.nn.sigmoid(dn_b.astype(jnp.float32).reshape(bsz, n, 2, DN_V_HEADS))
    g = -jnp.exp(dn_a_log.astype(jnp.float32)) * jax.nn.softplus(
        dn_a.astype(jnp.float32).reshape(bsz, n, 2, DN_V_HEADS) + dn_dt_bias.astype(jnp.float32))
    o_fwd = gated_delta_chunked(dq, dk_, dv_, g[:, :, 0], beta[:, :, 0])
    flip = lambda t: jnp.flip(t, axis=1)
    o_bwd = flip(gated_delta_chunked(flip(dq), flip(dk_), flip(dv_), flip(g[:, :, 1]), flip(beta[:, :, 1])))
    o_dn = rms_norm(o_fwd + o_bwd, dn_out_norm) * jax.nn.silu(
        dn_z.reshape(bsz, n, DN_V_HEADS, DN_DV).astype(jnp.float32))
    y_dn = o_dn.reshape(bsz, n, DN_Z_W).astype(h.dtype) @ w_dn_branch

    ang = axial_rope_angles(n)
    aq = apply_axial_rope(rms_norm(at_q.reshape(bsz, n, ATT_HEADS, HEAD_DIM), q_norm), ang)
    ak = apply_axial_rope(rms_norm(at_k.reshape(bsz, n, ATT_KV_HEADS, HEAD_DIM), k_norm), ang)
    av = at_v.reshape(bsz, n, ATT_KV_HEADS, HEAD_DIM)
    y_at = block_attention(aq, ak, av) @ w_attn_branch

    merged = jax.nn.sigmoid(gate_dn) * y_dn + jax.nn.sigmoid(gate_at) * y_at
    h = h + merged @ w_o

    hm = rms_norm(h, norm_mlp) @ w_up
    h = h + jnp.square(jax.nn.relu(hm)) @ w_down

    gate = jax.nn.sigmoid(rms_norm(h, norm_ple) @ w_ple_gate)
    h = h + gate * (pe.astype(h.dtype) @ w_ple)
    return h


def encoder_trunk(x, p, weights):
    h = x
    for i in range(DEPTH):
        h = encoder_layer(h, p[i], *[w[i] for w in weights])
    return h


def setup_inputs(seed: int = 0) -> dict:
    key = jax.random.key(seed)
    ks = jax.random.split(key, 22)
    f32 = jnp.float32

    def nrm(k, shape, scale):
        return jax.random.normal(k, shape, f32) * scale

    def gain(k, shape):
        return 1.0 + 0.02 * jax.random.normal(k, shape, f32)

    dt = jnp.exp(jax.random.uniform(ks[8], (DEPTH, 2, DN_V_HEADS), f32, math.log(1e-3), math.log(1e-1)))
    return {
        "x_prompt": nrm(ks[0], (BATCH, SEQ, D_MODEL), 1.0),
        "x_sample": nrm(ks[1], (DEC_BATCH, DEC_SEQ, D_MODEL), 1.0),
        "p_prompt": nrm(ks[2], (DEPTH, BATCH, SEQ, PLE_DIM), 1.0),
        "p_sample": nrm(ks[3], (DEPTH, DEC_BATCH, DEC_SEQ, PLE_DIM), 1.0),
        "norm_mix": gain(ks[4], (DEPTH, D_MODEL)),
        "w_in": nrm(ks[5], (DEPTH, D_MODEL, IN_COLS), D_MODEL ** -0.5),
        "dn_conv_w": nrm(ks[6], (DEPTH, DN_CONV, DN_QKV_W), DN_CONV ** -0.5),
        "dn_a_log": jnp.log(jax.random.uniform(ks[7], (DEPTH, 2, DN_V_HEADS), f32, 1.0, 16.0)),
        "dn_dt_bias": jnp.log(jnp.expm1(dt)),
        "dn_out_norm": gain(ks[9], (DEPTH, DN_DV)),
        "w_dn_branch": nrm(ks[10], (DEPTH, DN_Z_W, D_MODEL), DN_Z_W ** -0.5),
        "q_norm": gain(ks[11], (DEPTH, HEAD_DIM)),
        "k_norm": gain(ks[12], (DEPTH, HEAD_DIM)),
        "w_attn_branch": nrm(ks[13], (DEPTH, ATT_HEADS * HEAD_DIM, D_MODEL), (ATT_HEADS * HEAD_DIM) ** -0.5),
        "w_o": nrm(ks[14], (DEPTH, D_MODEL, D_MODEL), D_MODEL ** -0.5),
        "norm_mlp": gain(ks[15], (DEPTH, D_MODEL)),
        "w_up": nrm(ks[16], (DEPTH, D_MODEL, D_FF), D_MODEL ** -0.5),
        "w_down": nrm(ks[17], (DEPTH, D_FF, D_MODEL), D_FF ** -0.5),
        "norm_ple": gain(ks[18], (DEPTH, D_MODEL)),
        "w_ple_gate": nrm(ks[19], (DEPTH, D_MODEL, D_MODEL), D_MODEL ** -0.5),
        "w_ple": nrm(ks[20], (DEPTH, PLE_DIM, D_MODEL), PLE_DIM ** -0.5),
    }


def reference(x_prompt, x_sample, p_prompt, p_sample, norm_mix, w_in, dn_conv_w, dn_a_log,
              dn_dt_bias, dn_out_norm, w_dn_branch, q_norm, k_norm, w_attn_branch, w_o,
              norm_mlp, w_up, w_down, norm_ple, w_ple_gate, w_ple):
    weights = (norm_mix, w_in, dn_conv_w, dn_a_log, dn_dt_bias, dn_out_norm, w_dn_branch,
               q_norm, k_norm, w_attn_branch, w_o, norm_mlp, w_up, w_down, norm_ple,
               w_ple_gate, w_ple)
    y_prompt = encoder_trunk(x_prompt, p_prompt, weights)
    y_sample = encoder_trunk(x_sample, p_sample, weights)
    return (y_prompt, y_sample)
```

```cpp
#include <hip/hip_runtime.h>
#include <hip/hip_bf16.h>
#include <hip/hip_cooperative_groups.h>
#include <cstdio>
#include <cstdint>
namespace cg = cooperative_groups;
typedef unsigned short u16;
__device__ __forceinline__ int ltid() { int t = (int)threadIdx.x; asm volatile("" : "+v"(t)); return t; }
#ifndef DBG
#define DBG 0
#endif
#ifndef G4T
#define G4T 3
#endif
#ifndef G6T
#define G6T 15
#endif
#ifndef PHM
#define PHM 255
#endif
namespace pg8 {
#define PG8_LAS __attribute__((address_space(3)))
typedef unsigned short bf16_t;
typedef short bf16x8 __attribute__((ext_vector_type(8)));
typedef float f32x4 __attribute__((ext_vector_type(4)));
typedef unsigned u32x4 __attribute__((ext_vector_type(4)));
constexpr int BM = 256, BK = 64, HALF = 128, HTB = HALF * BK * 2  , STAGE_BYTES = 8 * HTB, NXCD = 8, WGM = 8;

__host__ __device__ __forceinline__ int lds_byte(int r, int c) { const int st = (r >> 4) * 2 + (c >> 5), rr = r & 15, cc = c & 31, ob = rr * 64 + cc * 2; return st * 1024 + (ob ^ (((ob >> 9) & 1) << 5)); }
__host__ __device__ __forceinline__ void stage_rc(int b, int& R, int& C) { const int st = b / 1024, sb = b % 1024, swz = sb ^ (((sb >> 9) & 1) << 5); R = (st >> 1) * 16 + swz / 64; C = (st & 1) * 32 + (swz % 64) / 2; }
__host__ __device__ __forceinline__ int perm32(int rho) { const int n = rho >> 4, i = rho & 15; return 8 * (i >> 2) + 4 * n + (i & 3); }

struct Unit { int pm, pn; };
struct Gemm { const bf16_t* A; const bf16_t* Bt; int M, N, K; };

struct StaticOrder {
    int nM, nN, nwg, G, c;
    __host__ __device__ void init(int M, int N, int G_, int c_) { nM = M / BM; nN = N / BM; nwg = nM * nN; G = G_; c = c_; }
    __host__ __device__ bool next(int i, Unit& u) const {
        const long L = (long)i * G + c; if (L >= nwg) return false;
        int wgid = (int)L; { const int q = nwg / NXCD, r = nwg % NXCD, xcd = wgid % NXCD, off = wgid / NXCD; wgid = (xcd < r ? xcd * (q + 1) : r * (q + 1) + (xcd - r) * q) + off; }
        const int nig = WGM * nN, gid = wgid / nig, fm = gid * WGM, gsz = (nM - fm) < WGM ? (nM - fm) : WGM;
        u.pm = fm + ((wgid % nig) % gsz); u.pn = (wgid % nig) / gsz; return true;
    }
    __device__ __forceinline__ void a_ready(const Unit&) const {}
    __device__ __forceinline__ void done(const Unit&) const {}
};
__device__ __forceinline__ unsigned cvt_pk_bf16(float lo, float hi) { unsigned r; asm volatile("v_cvt_pk_bf16_f32 %0, %1, %2" : "=v"(r) : "v"(lo), "v"(hi)); return r; }
typedef float f32x2 __attribute__((ext_vector_type(2)));
template <class Epi, class Sched, bool STAMP = false>
__device__ __forceinline__ void gemm_phase(PG8_LAS unsigned char* lds, const Gemm g, const Sched& S, const Epi& E, unsigned long long* stamps) {
    const int tid = ltid(), wid = __builtin_amdgcn_readfirstlane(tid >> 6), lane = tid & 63, wr = wid >> 2, wc = wid & 3, fr = lane & 15, fq = lane >> 4;
    const int K = g.K, nt = K / BK;
    int ts_lo = 0, ts_hi = 0, nts = 0; const unsigned long long rt_entry = STAMP ? (unsigned long long)wall_clock64() : 0ull;
#define PG8_STAMP() do { if (STAMP && wid == 0 && nts < 64) { const unsigned long long _c = (unsigned long long)clock64(); \
        ts_lo = (lane == nts) ? (int)(unsigned)_c : ts_lo; ts_hi = (lane == nts) ? (int)(unsigned)(_c >> 32) : ts_hi; ++nts; } } while (0)
    PG8_STAMP();
    unsigned voffA[2], voffB[2];
#pragma unroll
    for (int i = 0; i < 2; ++i) { int R, C; stage_rc(tid * 16 + i * 8192, R, C); const int Rb = E.perm ? ((R & ~31) + perm32(R & 31)) : R;
        voffA[i] = (unsigned)(R * K + C) * 2u; voffB[i] = (unsigned)(Rb * K + C) * 2u; }
    const size_t kstep = (size_t)(BK * 2);
    const size_t hstep = (size_t)HALF * K * 2;
    const size_t tstep = 2 * hstep;
    const unsigned ldsw = (unsigned)wid * 1024u;
    const int aoff = lds_byte(wr * 64 + fr, fq * 8), boff = lds_byte(wc * 32 + fr, fq * 8);
#define PG8_SA(b, h) (((b) * 2 + (h)) * HTB)
#define PG8_SB(b, h) ((4 + (b) * 2 + (h)) * HTB)
#define PG8_STAGE(bufoff, gbase, voff) do { _Pragma("unroll") for (int _i = 0; _i < 2; ++_i) \
        __builtin_amdgcn_global_load_lds((const unsigned*)((const char*)(gbase) + (voff)[_i]), (PG8_LAS unsigned*)(lds + (bufoff) + ldsw + _i * 8192), 16, 0, 0); } while (0)
#define PG8_LDA(dst, b, h) do { _Pragma("unroll") for (int m = 0; m < 4; ++m) _Pragma("unroll") for (int k = 0; k < 2; ++k) dst[m][k] = *(const PG8_LAS bf16x8*)(lds + PG8_SA(b, h) + aoff + m * 2048 + k * 1024); } while (0)
#define PG8_LDB(dst, b, h) do { _Pragma("unroll") for (int n = 0; n < 2; ++n) _Pragma("unroll") for (int k = 0; k < 2; ++k) dst[n][k] = *(const PG8_LAS bf16x8*)(lds + PG8_SB(b, h) + boff + n * 2048 + k * 1024); } while (0)
#define PG8_MMA(ai, bj, At, Bt) do { __builtin_amdgcn_s_setprio(1); _Pragma("unroll") for (int m = 0; m < 4; ++m) _Pragma("unroll") for (int n = 0; n < 2; ++n) _Pragma("unroll") for (int k = 0; k < 2; ++k) \
        acc[ai][bj][m][n] = __builtin_amdgcn_mfma_f32_16x16x32_bf16(Bt[n][k], At[m][k], acc[ai][bj][m][n], 0, 0, 0); __builtin_amdgcn_s_setprio(0); } while (0)
#define PG8_WAIT_V(n) asm volatile("s_waitcnt vmcnt(" #n ")" ::: "memory")
#define PG8_WAIT_L(n) asm volatile("s_waitcnt lgkmcnt(" #n ")" ::: "memory")
#define PG8_BAR __builtin_amdgcn_s_barrier()
#define PG8_SCHED __builtin_amdgcn_sched_barrier(0)
    Unit cur, nxt; int ui = 0;
    if (!S.next(0, cur)) return;
    f32x4 acc[2][2][4][2];
#pragma unroll
    for (int a = 0; a < 2; ++a)
#pragma unroll
        for (int b = 0; b < 2; ++b)
#pragma unroll
            for (int m = 0; m < 4; ++m)
#pragma unroll
                for (int n = 0; n < 2; ++n) acc[a][b][m][n] = (f32x4){0.f, 0.f, 0.f, 0.f};
    bf16x8 At[4][2], B0[2][2], B1[2][2];
    const char* cA = (const char*)g.A + (size_t)cur.pm * tstep; const char* cB = (const char*)g.Bt + (size_t)cur.pn * tstep;
    S.a_ready(cur);
    PG8_STAGE(PG8_SB(0, 0), cB, voffB); PG8_STAGE(PG8_SA(0, 0), cA, voffA); PG8_STAGE(PG8_SB(0, 1), cB + hstep, voffB); PG8_STAGE(PG8_SA(0, 1), cA + hstep, voffA);
    if (wr == 1) PG8_BAR;
    PG8_WAIT_V(4); PG8_BAR;
    PG8_STAGE(PG8_SB(1, 0), cB + kstep, voffB); PG8_STAGE(PG8_SA(1, 0), cA + kstep, voffA); PG8_STAGE(PG8_SB(1, 1), cB + hstep + kstep, voffB);
    PG8_WAIT_V(6); PG8_BAR;
    PG8_STAMP();
    for (;;) {
        const bool has_next = S.next(ui + 1, nxt);
        const char* nA = has_next ? (const char*)g.A + (size_t)nxt.pm * tstep : cA; const char* nB = has_next ? (const char*)g.Bt + (size_t)nxt.pn * tstep : cB;
        for (int t = 0; t < nt; t += 2) {
            const bool last = (t == nt - 2);
            const char* a1 = cA + (size_t)(t + 1) * kstep;
            const char* a2 = last ? nA : cA + (size_t)(t + 2) * kstep; const char* b2 = last ? nB : cB + (size_t)(t + 2) * kstep;
            const char* a3 = a2 + kstep; const char* b3 = b2 + kstep;
            if (last && has_next) S.a_ready(nxt);
            PG8_LDB(B0, 0, 0); PG8_SCHED; PG8_LDA(At, 0, 0); PG8_STAGE(PG8_SA(1, 1), a1 + hstep, voffA);
            PG8_WAIT_L(8); PG8_BAR; PG8_WAIT_L(0); PG8_MMA(0, 0, At, B0); PG8_BAR; PG8_SCHED;
            PG8_LDB(B1, 0, 1); PG8_STAGE(PG8_SB(0, 0), b2, voffB);
            PG8_BAR; PG8_WAIT_L(0); PG8_MMA(0, 1, At, B1); PG8_BAR;
            PG8_LDA(At, 0, 1); PG8_STAGE(PG8_SA(0, 0), a2, voffA);
            PG8_BAR; PG8_WAIT_L(0); PG8_MMA(1, 0, At, B0); PG8_BAR; PG8_SCHED;
            PG8_STAGE(PG8_SB(0, 1), b2 + hstep, voffB);
            PG8_WAIT_V(6); PG8_BAR; PG8_MMA(1, 1, At, B1); PG8_BAR;
            PG8_LDB(B0, 1, 0); PG8_SCHED; PG8_LDA(At, 1, 0); PG8_STAGE(PG8_SA(0, 1), a2 + hstep, voffA);
            PG8_WAIT_L(8); PG8_BAR; PG8_WAIT_L(0); PG8_MMA(0, 0, At, B0); PG8_BAR; PG8_SCHED;
            PG8_LDB(B1, 1, 1); PG8_STAGE(PG8_SB(1, 0), b3, voffB);
            PG8_BAR; PG8_WAIT_L(0); PG8_MMA(0, 1, At, B1); PG8_BAR;
            PG8_LDA(At, 1, 1); PG8_STAGE(PG8_SA(1, 0), a3, voffA);
            PG8_BAR; PG8_WAIT_L(0); PG8_MMA(1, 0, At, B0); PG8_BAR; PG8_SCHED;
            PG8_STAGE(PG8_SB(1, 1), b3 + hstep, voffB);
            PG8_WAIT_V(6); PG8_BAR; PG8_MMA(1, 1, At, B1); PG8_BAR;
        }
        PG8_STAMP();
        if constexpr (!Epi::AFTER_DRAIN) { E(acc, cur, wr, wc, fr, fq); S.done(cur); }
        PG8_STAMP();
        if (!has_next) break;
#pragma unroll
        for (int a = 0; a < 2; ++a)
#pragma unroll
            for (int b = 0; b < 2; ++b)
#pragma unroll
                for (int m = 0; m < 4; ++m)
#pragma unroll
                    for (int n = 0; n < 2; ++n) acc[a][b][m][n] = (f32x4){0.f, 0.f, 0.f, 0.f};
        cur = nxt; cA = nA; cB = nB; ++ui;
    }
    PG8_WAIT_V(0);
    if (wr == 0) PG8_BAR;
    PG8_BAR;
    if constexpr (Epi::AFTER_DRAIN) { E.fused(acc, cur, wr, wc, fr, fq, lds, wid, lane); S.done(cur); }
    PG8_STAMP();
    if (STAMP && wid == 0) { stamps[lane] = lane < nts ? (((unsigned long long)(unsigned)ts_hi << 32) | (unsigned)ts_lo) : 0ull;
        if (lane == 62) stamps[62] = rt_entry; if (lane == 63) stamps[63] = (unsigned long long)wall_clock64(); }
#undef PG8_STAMP
#undef PG8_SA
#undef PG8_SB
#undef PG8_STAGE
#undef PG8_LDA
#undef PG8_LDB
#undef PG8_MMA
#undef PG8_WAIT_V
#undef PG8_WAIT_L
#undef PG8_BAR
#undef PG8_SCHED
}
}
namespace att {
using bf16 = __hip_bfloat16;
constexpr int   D = 128, NW = 8, QBLK = 32, KVBLK = 64;
constexpr float SCALE = 0.088388347648318440f;
constexpr float THR = 8.f;
constexpr int SDEPTH = 2;
constexpr int LDQ = 1024, LDK = 256, LDO = 1024;
constexpr size_t SHM_V = KVBLK * D * 2, SHM_K = KVBLK * D * 2, SHM_ATTN = 2 * SHM_V + 2 * SHM_K + NW * 64 * 4;
using bf16x8 = __attribute__((ext_vector_type(8))) short;
using s16x4  = __attribute__((ext_vector_type(4))) short;
using f32x16 = __attribute__((ext_vector_type(16))) float;
using f32x8  = __attribute__((ext_vector_type(8))) float;
using u32x4  = __attribute__((ext_vector_type(4))) unsigned;
#define KSWZ(row, colB) ((row) * 256 + ((colB) ^ (((row) & 7) << 4)))
#define SBAR() __builtin_amdgcn_sched_barrier(0)
__device__ __forceinline__ int crow(int r, int hi) { return (r & 3) + 8 * (r >> 2) + 4 * hi; }
__device__ __forceinline__ unsigned cvtpk(float lo, float hi) {
  unsigned r; asm volatile("v_cvt_pk_bf16_f32 %0, %1, %2" : "=v"(r) : "v"(lo), "v"(hi)); return r;
}
template <typename TIn> struct Stage;
template <> struct Stage<bf16>  { using T = bf16x8;
  __device__ static __forceinline__ T ld8(const bf16* p) { return *reinterpret_cast<const bf16x8*>(p); }
  __device__ static __forceinline__ bf16x8 tobf(T x) { return x; } };
template <> struct Stage<float> { using T = f32x8;
  __device__ static __forceinline__ T ld8(const float* p) { return *reinterpret_cast<const f32x8*>(p); }
  __device__ static __forceinline__ bf16x8 tobf(T x) {
    u32x4 w = {cvtpk(x[0], x[1]), cvtpk(x[2], x[3]), cvtpk(x[4], x[5]), cvtpk(x[6], x[7])}; return *reinterpret_cast<bf16x8*>(&w); } };

__device__ __forceinline__ void partialSM(f32x16& p0, f32x16& p1, float& m_reg, float& mn, float& alpha) {
  constexpr float C = SCALE * 1.4426950408889634f;
  float pmax = p0[0]; for (int r = 1; r < 16; ++r) pmax = fmaxf(pmax, p0[r]); for (int r = 0; r < 16; ++r) pmax = fmaxf(pmax, p1[r]);
  { auto rr = __builtin_amdgcn_permlane32_swap(__float_as_uint(pmax), __float_as_uint(pmax), false, false);
    pmax = fmaxf(__uint_as_float(rr[0]), __uint_as_float(rr[1])); }
  if (__builtin_expect(__all(pmax - m_reg <= THR / SCALE), 1)) { mn = m_reg; alpha = 1.f; }
  else { mn = fmaxf(m_reg, pmax); alpha = __builtin_amdgcn_exp2f((m_reg - mn) * C); m_reg = mn; }
  float mnC = -mn * C;
  for (int r = 0; r < 16; ++r) p0[r] = fmaf(p0[r], C, mnC); for (int r = 0; r < 16; ++r) p1[r] = fmaf(p1[r], C, mnC);
  for (int r = 0; r < 16; ++r) p0[r] = __builtin_amdgcn_exp2f(p0[r]);
}
__device__ __forceinline__ void finishSM(f32x16& p0, f32x16& p1, float alpha, float& l_reg, bf16x8& pa0, bf16x8& pa1, bf16x8& pa2, bf16x8& pa3) {
  for (int r = 0; r < 16; ++r) p1[r] = __builtin_amdgcn_exp2f(p1[r]);
  float ps = 0; for (int r = 0; r < 16; ++r) ps += p0[r]; for (int r = 0; r < 16; ++r) ps += p1[r];
  { auto rr = __builtin_amdgcn_permlane32_swap(__float_as_uint(ps), __float_as_uint(ps), false, false);
    ps = __uint_as_float(rr[0]) + __uint_as_float(rr[1]); }
  l_reg = l_reg * alpha + ps;
#define PK4(P, BASE, OUT) do { unsigned a0 = cvtpk(P[BASE + 0], P[BASE + 1]), a1 = cvtpk(P[BASE + 2], P[BASE + 3]);   \
    unsigned b0 = cvtpk(P[BASE + 4], P[BASE + 5]), b1 = cvtpk(P[BASE + 6], P[BASE + 7]);                              \
    auto r0 = __builtin_amdgcn_permlane32_swap(a0, b0, false, false); auto r1 = __builtin_amdgcn_permlane32_swap(a1, b1, false, false); \
    u32x4 w = {r0[0], r1[0], r0[1], r1[1]}; OUT = *reinterpret_cast<bf16x8*>(&w); } while (0)
  PK4(p0, 0, pa0); PK4(p0, 8, pa1); PK4(p1, 0, pa2); PK4(p1, 8, pa3);
#undef PK4
}
__device__ __forceinline__ void qkt(f32x16& p0, f32x16& p1, const bf16* Ks, const bf16x8* qr, int r32, int hi) {
  p0 = f32x16{}; p1 = f32x16{};
  for (int d0 = 0; d0 < 8; ++d0) { int cb = (d0 * 16 + hi * 8) * 2;
    bf16x8 b0 = *reinterpret_cast<const bf16x8*>((const char*)Ks + KSWZ(r32, cb));
    bf16x8 b1 = *reinterpret_cast<const bf16x8*>((const char*)Ks + KSWZ(32 + r32, cb));
    p0 = __builtin_amdgcn_mfma_f32_32x32x16_bf16(b0, qr[d0], p0, 0, 0, 0);
    p1 = __builtin_amdgcn_mfma_f32_32x32x16_bf16(b1, qr[d0], p1, 0, 0, 0); }
}
__device__ __forceinline__ int v_st(int k, int c) { const int kk = (k & ~0xC) | ((k & 4) << 1) | ((k & 8) >> 1); return ((kk >> 3) * 4 + (c >> 5)) * 512 + ((kk & 7) * 32 + (c & 31)) * 2; }
__device__ __forceinline__ int v_rd_base(int lane) { return ((lane & 3) << 3) | (((lane >> 2) & 3) << 6) | (((lane >> 4) & 1) << 5) | (((lane >> 5) & 1) << 8); }
constexpr int v_rd_off(int d0, int ks, int half) { return d0 * 512 + ks * 4096 + half * 2048; }
template <int OFF> __device__ __forceinline__ s16x4 tr_read(int vb) {
  s16x4 r; asm volatile("ds_read_b64_tr_b16 %0, %1 offset:%2" : "=&v"(r) : "v"(vb), "i"(OFF) : "memory"); return r;
}
template <int D0> __device__ __forceinline__ void pv_one(f32x16& od, int vb, bf16x8 pa0, bf16x8 pa1, bf16x8 pa2, bf16x8 pa3) {
  const s16x4 l0 = tr_read<v_rd_off(D0, 0, 0)>(vb), h0 = tr_read<v_rd_off(D0, 0, 1)>(vb), l1 = tr_read<v_rd_off(D0, 1, 0)>(vb), h1 = tr_read<v_rd_off(D0, 1, 1)>(vb);
  const s16x4 l2 = tr_read<v_rd_off(D0, 2, 0)>(vb), h2 = tr_read<v_rd_off(D0, 2, 1)>(vb), l3 = tr_read<v_rd_off(D0, 3, 0)>(vb), h3 = tr_read<v_rd_off(D0, 3, 1)>(vb);
  asm volatile("s_waitcnt lgkmcnt(0)" ::: "memory"); SBAR();
#define PK(L, H) (bf16x8){L[0], L[1], L[2], L[3], H[0], H[1], H[2], H[3]}
  od = __builtin_amdgcn_mfma_f32_32x32x16_bf16(pa0, PK(l0, h0), od, 0, 0, 0);
  od = __builtin_amdgcn_mfma_f32_32x32x16_bf16(pa1, PK(l1, h1), od, 0, 0, 0);
  od = __builtin_amdgcn_mfma_f32_32x32x16_bf16(pa2, PK(l2, h2), od, 0, 0, 0);
  od = __builtin_amdgcn_mfma_f32_32x32x16_bf16(pa3, PK(l3, h3), od, 0, 0, 0);
#undef PK
}
__device__ __forceinline__ void pv_d0(f32x16* o, int vb, bf16x8 pa0, bf16x8 pa1, bf16x8 pa2, bf16x8 pa3) {
  pv_one<0>(o[0], vb, pa0, pa1, pa2, pa3); pv_one<1>(o[1], vb, pa0, pa1, pa2, pa3); pv_one<2>(o[2], vb, pa0, pa1, pa2, pa3); pv_one<3>(o[3], vb, pa0, pa1, pa2, pa3);
}

template <typename TQ>
__device__ __forceinline__ void attn_dense_body(const TQ* Qb, const bf16* __restrict__ Kh, const bf16* __restrict__ Vh,
                                                bf16* Ob, int seq, char* lds) {
  using St = Stage<bf16>; using SQ = Stage<TQ>;
  const int tid = ltid(), wid = tid >> 6, lane = tid & 63, r32 = lane & 31, hi = lane >> 5;
  bf16* V_lds = (bf16*)lds; bf16* K_lds = (bf16*)(lds + 2 * SHM_V);
  float* ws = (float*)(lds + 2 * SHM_V + 2 * SHM_K) + wid * 64; float* li_l = ws; float* al_l = ws + 32;
  float m_reg = -1e30f, l_reg = 0; f32x16 o[4] = {}; bf16x8 qr[8];
  const TQ* Qw = Qb + (long)(wid * QBLK + r32) * LDQ + hi * 8;
#pragma unroll
  for (int d0 = 0; d0 < 8; ++d0) qr[d0] = SQ::tobf(SQ::ld8(Qw + d0 * 16));
  const int sr = tid >> 4, sc = (tid & 15) * 8, vst0 = v_st(sr, sc), vst1 = v_st(32 + sr, sc);
  const int vb0 = (int)(uintptr_t)V_lds + v_rd_base(lane);
  struct { typename St::T vs0, vs1, ks0, ks1; } sr_[SDEPTH];
#define SLOAD(i, k0) do { sr_[i].vs0 = St::ld8(&Vh[(long)((k0) + sr) * LDK + sc]); sr_[i].vs1 = St::ld8(&Vh[(long)((k0) + 32 + sr) * LDK + sc]); \
    sr_[i].ks0 = St::ld8(&Kh[(long)((k0) + sr) * LDK + sc]); sr_[i].ks1 = St::ld8(&Kh[(long)((k0) + 32 + sr) * LDK + sc]); } while (0)
#define SWRITE(b, i) do { *(bf16x8*)((char*)V_lds + (b) * SHM_V + vst0) = St::tobf(sr_[i].vs0);          \
    *(bf16x8*)((char*)V_lds + (b) * SHM_V + vst1) = St::tobf(sr_[i].vs1); int kc = sc * 2;               \
    *(bf16x8*)((char*)K_lds + (b) * SHM_K + KSWZ(sr, kc)) = St::tobf(sr_[i].ks0);                       \
    *(bf16x8*)((char*)K_lds + (b) * SHM_K + KSWZ(32 + sr, kc)) = St::tobf(sr_[i].ks1); } while (0)
#define SWAIT() do { if constexpr (SDEPTH == 2) asm volatile("s_waitcnt vmcnt(4)" ::: "memory"); else asm volatile("s_waitcnt vmcnt(0)" ::: "memory"); } while (0)
#define RESC(a) do { if (__any((a) < 1.f)) { if (hi == 0) al_l[r32] = (a); asm volatile("s_waitcnt lgkmcnt(0)" ::: "memory"); \
    for (int d = 0; d < 4; ++d) for (int r = 0; r < 16; ++r) o[d][r] *= al_l[crow(r, hi)]; } } while (0)
  f32x16 pA0, pA1, pB0, pB1; float mnA, mnB, alA, alB; bf16x8 pa0, pa1, pa2, pa3; const int NT = seq / KVBLK;
  constexpr int SE = 0, SO = SDEPTH - 1;
  SLOAD(SE, 0); asm volatile("s_waitcnt vmcnt(0)" ::: "memory"); SWRITE(0, SE); __syncthreads();
  qkt(pA0, pA1, K_lds, qr, r32, hi); partialSM(pA0, pA1, m_reg, mnA, alA);
  SLOAD(SO, KVBLK); if constexpr (SDEPTH == 2) { if (2 < NT) SLOAD(SE, 2 * KVBLK); }
  SWAIT(); SWRITE(1, SO); __syncthreads();
  for (int j = 1; j + 1 < NT; j += 2) {
    SBAR(); qkt(pB0, pB1, (bf16*)((char*)K_lds + SHM_K), qr, r32, hi);
    finishSM(pA0, pA1, alA, l_reg, pa0, pa1, pa2, pa3); SBAR();
    SLOAD(SO, (j + SDEPTH) * KVBLK); SBAR();
    pv_d0(o, vb0, pa0, pa1, pa2, pa3); partialSM(pB0, pB1, m_reg, mnB, alB);
    __syncthreads(); SWAIT(); SWRITE(0, SE);
    RESC(alB); __syncthreads();
    SBAR(); qkt(pA0, pA1, K_lds, qr, r32, hi);
    finishSM(pB0, pB1, alB, l_reg, pa0, pa1, pa2, pa3); SBAR();
    if (SDEPTH == 1 || j + 3 < NT) SLOAD(SE, (j + 1 + SDEPTH) * KVBLK); SBAR();
    pv_d0(o, vb0 + (int)SHM_V, pa0, pa1, pa2, pa3); partialSM(pA0, pA1, m_reg, mnA, alA);
    __syncthreads(); SWAIT(); SWRITE(1, SO);
    RESC(alA); __syncthreads();
  }
  SBAR(); qkt(pB0, pB1, (bf16*)((char*)K_lds + SHM_K), qr, r32, hi);
  finishSM(pA0, pA1, alA, l_reg, pa0, pa1, pa2, pa3); SBAR();
  pv_d0(o, vb0, pa0, pa1, pa2, pa3); partialSM(pB0, pB1, m_reg, mnB, alB);
  __syncthreads(); RESC(alB);
  finishSM(pB0, pB1, alB, l_reg, pa0, pa1, pa2, pa3); SBAR();
  pv_d0(o, vb0 + (int)SHM_V, pa0, pa1, pa2, pa3);
  if (hi == 0) li_l[r32] = l_reg; asm volatile("s_waitcnt lgkmcnt(0)" ::: "memory");
  float rli[16];
#pragma unroll
  for (int r = 0; r < 16; ++r) rli[r] = __builtin_amdgcn_rcpf(li_l[crow(r, hi)]);
  bf16* Ow = Ob + (long)(wid * QBLK) * LDO;
#pragma unroll
  for (int r = 0; r < 16; ++r) { int orow = crow(r, hi);
    for (int d0 = 0; d0 < 4; ++d0) Ow[(long)orow * LDO + d0 * 32 + r32] = __float2bfloat16(o[d0][r] * rli[r]); }
#undef SLOAD
#undef SWRITE
#undef SWAIT
#undef RESC
}
}
typedef short bf16x8 __attribute__((ext_vector_type(8)));
typedef float f32x4 __attribute__((ext_vector_type(4)));
typedef float f32x16 __attribute__((ext_vector_type(16)));
typedef unsigned u32x4 __attribute__((ext_vector_type(4)));
typedef unsigned u32x2 __attribute__((ext_vector_type(2)));
constexpr size_t MiB = 1ull << 20;
constexpr int MALL = 32768, MG = 16384;
constexpr size_t OFF_WIN = 0, OFF_WBA = 13 * MiB, OFF_WDN = 14 * MiB, OFF_WAT = 16 * MiB, OFF_WO = 18 * MiB, OFF_WUP = 20 * MiB, OFF_WDA = 28 * MiB, OFF_WDB = 32 * MiB,
                 OFF_WPG = 36 * MiB, OFF_WPLE = 38 * MiB, OFF_U = 39 * MiB, OFF_MERGED = 103 * MiB, OFF_ATK = 135 * MiB, OFF_ATV = 143 * MiB, OFF_QN = 167 * MiB,
                 OFF_KN = 183 * MiB, OFF_KT = 199 * MiB, OFF_VF = 215 * MiB, OFF_BETA = 247 * MiB, OFF_G = 249 * MiB, OFF_AUX = 251 * MiB, OFF_CTR = 255 * MiB,
                 OFF_HM = 103 * MiB, OFF_PE = 231 * MiB, OFF_GBUF = 103 * MiB;
constexpr size_t OO_SLOT = 0, OO_ATQ = 64 * MiB, OO_SZ = 96 * MiB, OO_BUFA = 0, OO_BUFB = 32 * MiB;
constexpr int LDS_BYTES = 136 * 1024 + 64;
constexpr int NPHASE = 21;

struct Params { const float* in[21]; float* out; unsigned char* ws; int ph_lo, ph_hi; };

__device__ __forceinline__ float bf2f(u16 b) { return __uint_as_float(((unsigned)b) << 16); }
__device__ __forceinline__ u16 f2bf(float f) { unsigned u = __float_as_uint(f); u += 0x7FFFu + ((u >> 16) & 1u); return (u16)(u >> 16); }
typedef __bf16 bf16x2_t __attribute__((ext_vector_type(2)));
typedef float f32x2_t __attribute__((ext_vector_type(2)));
__device__ __forceinline__ unsigned pk2(float lo, float hi) { f32x2_t f = {lo, hi}; bf16x2_t b = __builtin_convertvector(f, bf16x2_t); return __builtin_bit_cast(unsigned, b); }
__device__ __forceinline__ float sigm(float x) { return 1.0f / (1.0f + __expf(-x)); }
__device__ __forceinline__ int swap23(int j) { return (j & ~0xC) | ((j & 4) << 1) | ((j & 8) >> 1); }
__device__ __forceinline__ int crow(int r, int hi) { return (r & 3) + 8 * (r >> 2) + 4 * hi; }
__device__ __forceinline__ bf16x8 pack8(const f32x16& v, int base) {
    u32x4 w = {pk2(v[base], v[base + 1]), pk2(v[base + 2], v[base + 3]), pk2(v[base + 4], v[base + 5]), pk2(v[base + 6], v[base + 7])};
    return *reinterpret_cast<bf16x8*>(&w);
}
#define MFMA32(a, b, c) __builtin_amdgcn_mfma_f32_32x32x16_bf16(a, b, c, 0, 0, 0)

enum { E_IN = 0, E_SIG, E_MULRMW, E_MERGE, E_RELU2, E_RES, E_ACC, E_SIG4, E_PLE };
struct GEpi {
    static constexpr bool AFTER_DRAIN = false;
    int mode, perm, ld, pad; u16 *o1, *o2, *o3, *o4, *o5; float* C; const float *r0, *r1;
    __device__ __forceinline__ void operator()(const pg8::f32x4 (&acc)[2][2][4][2], const pg8::Unit& u, int wr, int wc, int fr, int fq) const {
        using namespace pg8;
        const int row0 = u.pm * BM + wr * 64 + fr;
        if (perm) {
            u16* base = o1; u16* dst = o1; int ldd = ld; int colt = u.pn * BM; bool act = false;
            if (mode == E_IN) {
                if (u.pn < 8) { base = o1; ldd = 2048; colt = u.pn * 256; }
                else if (u.pn < 12) { base = o2; ldd = 1024; colt = (u.pn - 8) * 256; }
                else if (u.pn == 12) { base = o3; ldd = 256; colt = 0; }
                else if (u.pn == 13) { base = o4; ldd = 256; colt = 0; }
                else { base = o5; ldd = 1024; colt = (u.pn - 14) * 256; act = true; }
                dst = base;
            }
            if (mode == E_MERGE) dst = o3;
            const int col0 = colt + wc * 32 + 8 * fq;
#pragma unroll
            for (int ai = 0; ai < 2; ++ai)
#pragma unroll
                for (int m = 0; m < 4; ++m) {
                    const size_t roff = (size_t)(row0 + ai * HALF + m * 16) * ldd + col0;
#pragma unroll
                    for (int bj = 0; bj < 2; ++bj) {
                        f32x4 v0 = acc[ai][bj][m][0], v1 = acc[ai][bj][m][1];
                        float v[8] = {v0[0], v0[1], v0[2], v0[3], v1[0], v1[1], v1[2], v1[3]};
                        if (mode == E_IN) { if (act) {
#pragma unroll
                            for (int j = 0; j < 8; ++j) v[j] = v[j] * sigm(v[j]); } }
                        else if (mode == E_SIG) {
#pragma unroll
                            for (int j = 0; j < 8; ++j) v[j] = sigm(v[j]); }
                        else if (mode == E_RELU2) {
#pragma unroll
                            for (int j = 0; j < 8; ++j) { float t = fmaxf(v[j], 0.f); v[j] = t * t; } }
                        else if (mode == E_MULRMW) {
                            const u32x4 g = *(const u32x4*)(o1 + roff + bj * HALF);
#pragma unroll
                            for (int j = 0; j < 4; ++j) { v[2 * j] *= __uint_as_float(g[j] << 16); v[2 * j + 1] *= __uint_as_float(g[j] & 0xffff0000u); } }
                        else {
                            const u32x4 a = *(const u32x4*)(o1 + roff + bj * HALF); const u32x4 g = *(const u32x4*)(o2 + roff + bj * HALF);
#pragma unroll
                            for (int j = 0; j < 4; ++j) { v[2 * j] = __uint_as_float(a[j] << 16) + v[2 * j] * __uint_as_float(g[j] << 16);
                                v[2 * j + 1] = __uint_as_float(a[j] & 0xffff0000u) + v[2 * j + 1] * __uint_as_float(g[j] & 0xffff0000u); } }
#if DBG & 1
                        if (mode == E_MERGE) {
#pragma unroll
                            for (int j = 0; j < 8; ++j) v[j] = 0.f; }
#endif
#if DBG & 2
                        if (mode == E_MULRMW) {
#pragma unroll
                            for (int j = 0; j < 8; ++j) v[j] = 0.f; }
#endif
                        u32x4 w; w.x = pk2(v[0], v[1]); w.y = pk2(v[2], v[3]); w.z = pk2(v[4], v[5]); w.w = pk2(v[6], v[7]);
                        *(u32x4*)(dst + roff + bj * HALF) = w;
                    }
                    asm volatile("" ::: "memory");
                }
        } else {
            const int col0 = u.pn * BM + wc * 32 + 4 * fq;
#pragma unroll
            for (int ai = 0; ai < 2; ++ai)
#pragma unroll
                for (int m = 0; m < 4; ++m) {
                    const int row = row0 + ai * HALF + m * 16;
                    const size_t roff = (size_t)row * ld + col0;
                    const float* rp = (row < MG) ? (r0 + (size_t)row * ld) : (r1 + (size_t)(row - MG) * ld);
#pragma unroll
                    for (int bj = 0; bj < 2; ++bj)
#pragma unroll
                        for (int n = 0; n < 2; ++n) {
                            const size_t off = roff + bj * HALF + n * 16; f32x4 a = acc[ai][bj][m][n];
                            if (mode == E_RES) { const f32x4 x = *(const f32x4*)(rp + col0 + bj * HALF + n * 16); *(f32x4*)(C + off) = x + a; }
                            else if (mode == E_ACC) { const f32x4 x = *(const f32x4*)(C + off); *(f32x4*)(C + off) = x + a; }
                            else if (mode == E_SIG4) { u32x2 w; w.x = pk2(sigm(a[0]), sigm(a[1])); w.y = pk2(sigm(a[2]), sigm(a[3])); *(u32x2*)(o1 + off) = w; }
                            else { const u32x2 g = *(const u32x2*)(o1 + off); const f32x4 x = *(const f32x4*)(C + off);
                                f32x4 o; o[0] = x[0] + __uint_as_float(g.x << 16) * a[0]; o[1] = x[1] + __uint_as_float(g.x & 0xffff0000u) * a[1];
                                o[2] = x[2] + __uint_as_float(g.y << 16) * a[2]; o[3] = x[3] + __uint_as_float(g.y & 0xffff0000u) * a[3]; *(f32x4*)(C + off) = o; }
                        }
                    asm volatile("" ::: "memory");
                }
        }
    }
};
struct GDesc { const u16* A; const u16* Bt; int M, N, K; GEpi e; };
__device__ __forceinline__ bool get_desc(const Params& p, int ph, int k, GDesc& d) {
    unsigned char* ws = p.ws; unsigned char* O = (unsigned char*)p.out;
    d.e = GEpi{}; d.e.perm = 1; d.e.ld = 1024; d.M = MALL; d.N = 1024; d.K = 1024;
    if (ph >= 1 && ph <= 12) {
        const int g = (ph - 1) / 6, sp = (ph - 1) % 6;
        const u16* ug = (const u16*)(ws + OFF_U) + (size_t)g * MG * 1024;
        d.M = MG;
        if (sp == 0) { if (k > 0) return false;
            d.A = ug; d.Bt = (const u16*)(ws + OFF_WIN); d.N = 4608; d.e.mode = E_IN;
            d.e.o1 = (u16*)(O + OO_SLOT); d.e.o2 = (u16*)(O + OO_ATQ); d.e.o3 = (u16*)(ws + OFF_ATK); d.e.o4 = (u16*)(ws + OFF_ATV); d.e.o5 = (u16*)(O + OO_SZ); return true; }
        if (sp != 5 || k > 3) return false;
        u16* bufA = (u16*)(O + OO_BUFA); u16* bufB = (u16*)(O + OO_BUFB); u16* merged = (u16*)(ws + OFF_MERGED) + (size_t)g * MG * 1024;
        if (k == 0) { d.A = ug; d.Bt = (const u16*)(ws + OFF_WIN) + (size_t)4608 * 1024; d.e.mode = E_SIG; d.e.o1 = bufA; }
        else if (k == 1) { d.A = (const u16*)(O + OO_SZ); d.Bt = (const u16*)(ws + OFF_WDN); d.e.mode = E_MULRMW; d.e.o1 = bufA; }
        else if (k == 2) { d.A = ug; d.Bt = (const u16*)(ws + OFF_WIN) + (size_t)5632 * 1024; d.e.mode = E_SIG; d.e.o1 = bufB; }
        else { d.A = (const u16*)(O + OO_ATQ); d.Bt = (const u16*)(ws + OFF_WAT); d.e.mode = E_MERGE; d.e.o1 = bufA; d.e.o2 = bufB; d.e.o3 = merged; }
        return true;
    }
    if (ph == 13) { if (k > 0) return false; d.A = (const u16*)(ws + OFF_MERGED); d.Bt = (const u16*)(ws + OFF_WO); d.e.mode = E_RES; d.e.perm = 0; d.e.C = p.out; d.e.r0 = p.in[0]; d.e.r1 = p.in[1]; return true; }
    if (ph == 15 || ph == 17) { if (k > 1) return false; d.A = (const u16*)(ws + OFF_U); d.Bt = (const u16*)(ws + OFF_WUP) + (ph == 17 ? (size_t)2048 * 1024 : 0) + (size_t)k * 1024 * 1024; d.N = 1024; d.e.mode = E_RELU2; d.e.o1 = (u16*)(ws + OFF_HM) + k * 1024; d.e.ld = 2048; return true; }
    if (ph == 16 || ph == 18) { if (k > 0) return false; d.A = (const u16*)(ws + OFF_HM); d.Bt = (const u16*)(ws + (ph == 16 ? OFF_WDA : OFF_WDB)); d.K = 2048; d.e.mode = E_ACC; d.e.perm = 0; d.e.C = p.out; return true; }
    if (ph == 20) { if (k > 1) return false;
        if (k == 0) { d.A = (const u16*)(ws + OFF_U); d.Bt = (const u16*)(ws + OFF_WPG); d.e.mode = E_SIG4; d.e.perm = 0; d.e.o1 = (u16*)(ws + OFF_GBUF); }
        else { d.A = (const u16*)(ws + OFF_PE); d.Bt = (const u16*)(ws + OFF_WPLE); d.K = 256; d.e.mode = E_PLE; d.e.perm = 0; d.e.o1 = (u16*)(ws + OFF_GBUF); d.e.C = p.out; }
        return true; }
    return false;
}

__device__ __forceinline__ void tconv_unit(const float* __restrict__ src, int ld, int col0, int ncols, int K, u16* __restrict__ dst, int unit, float* tile) {
    const int nK = K / 64, kt = unit % nK, nt = unit / nK, k0 = kt * 64, n0 = nt * 64, tid = ltid(), a = tid & 63, b = tid >> 6;
#pragma unroll
    for (int i = 0; i < 8; ++i) { const int k = b + 8 * i, n = n0 + a; tile[k * 65 + a] = (n < ncols) ? src[(size_t)(k0 + k) * ld + col0 + n] : 0.f; }
    __syncthreads();
#pragma unroll
    for (int i = 0; i < 8; ++i) { const int nn = b + 8 * i; if (n0 + nn < ncols) dst[(size_t)(n0 + nn) * K + k0 + a] = f2bf(tile[a * 65 + nn]); }
    __syncthreads();
}
__device__ void phase_tconv(const Params& p, float* tile) {
    u16* ws = (u16*)p.ws;
    constexpr int NJ = 13;
    const int cum[NJ + 1] = {0, 512, 896, 1152, 1664, 1680, 1936, 2192, 2448, 3472, 3984, 4496, 4752, 4816};
    for (int uu = blockIdx.x; uu < 4816; uu += gridDim.x) {
        int j = 0;
#pragma unroll
        for (int q = 1; q < NJ; ++q) if (uu >= cum[q]) j = q;
        const int unit = uu - cum[j];
        const float* src; int ld, col0, ncols, K; size_t doff;
        switch (j) {
            case 0: src = p.in[5]; ld = 6688; col0 = 0; ncols = 2048; K = 1024; doff = OFF_WIN; break;
            case 1: src = p.in[5]; ld = 6688; col0 = 3104; ncols = 1536; K = 1024; doff = OFF_WIN + (size_t)2048 * 2048; break;
            case 2: src = p.in[5]; ld = 6688; col0 = 2048; ncols = 1024; K = 1024; doff = OFF_WIN + (size_t)3584 * 2048; break;
            case 3: src = p.in[5]; ld = 6688; col0 = 4640; ncols = 2048; K = 1024; doff = OFF_WIN + (size_t)4608 * 2048; break;
            case 4: src = p.in[5]; ld = 6688; col0 = 3072; ncols = 32; K = 1024; doff = OFF_WBA; break;
            case 5: src = p.in[10]; ld = 1024; col0 = 0; ncols = 1024; K = 1024; doff = OFF_WDN; break;
            case 6: src = p.in[13]; ld = 1024; col0 = 0; ncols = 1024; K = 1024; doff = OFF_WAT; break;
            case 7: src = p.in[14]; ld = 1024; col0 = 0; ncols = 1024; K = 1024; doff = OFF_WO; break;
            case 8: src = p.in[16]; ld = 4096; col0 = 0; ncols = 4096; K = 1024; doff = OFF_WUP; break;
            case 9: src = p.in[17]; ld = 1024; col0 = 0; ncols = 1024; K = 2048; doff = OFF_WDA; break;
            case 10: src = p.in[17] + (size_t)2048 * 1024; ld = 1024; col0 = 0; ncols = 1024; K = 2048; doff = OFF_WDB; break;
            case 11: src = p.in[19]; ld = 1024; col0 = 0; ncols = 1024; K = 1024; doff = OFF_WPG; break;
            default: src = p.in[20]; ld = 1024; col0 = 0; ncols = 1024; K = 256; doff = OFF_WPLE; break;
        }
        tconv_unit(src, ld, col0, ncols, K, (u16*)(p.ws + doff), unit, tile);
    }
    (void)ws;
}
__device__ __forceinline__ void rmsnorm_row(const float* __restrict__ xr, const float* __restrict__ gain, u16* __restrict__ dst, int lane) {
    f32x4 v[4]; float ss = 0.f;
#pragma unroll
    for (int i = 0; i < 4; ++i) { v[i] = *(const f32x4*)(xr + i * 256 + lane * 4); ss += v[i][0] * v[i][0] + v[i][1] * v[i][1] + v[i][2] * v[i][2] + v[i][3] * v[i][3]; }
#pragma unroll
    for (int o = 32; o >= 1; o >>= 1) ss += __shfl_xor(ss, o);
    const float rs = rsqrtf(ss * (1.0f / 1024.0f) + 1e-6f);
#pragma unroll
    for (int i = 0; i < 4; ++i) { const f32x4 g = *(const f32x4*)(gain + i * 256 + lane * 4);
        u32x2 w; w.x = pk2(v[i][0] * rs * g[0], v[i][1] * rs * g[1]); w.y = pk2(v[i][2] * rs * g[2], v[i][3] * rs * g[3]);
        *(u32x2*)(dst + i * 256 + lane * 4) = w; }
}
__device__ void phase_rmsnorm(const float* x0, const float* x1, const float* gain, u16* dst) {
    const int lane = ltid() & 63, gw = blockIdx.x * 8 + __builtin_amdgcn_readfirstlane(ltid() >> 6), nw = gridDim.x * 8;
    for (int r = gw; r < MALL; r += nw) {
        const float* xr = (r < MG) ? x0 + (size_t)r * 1024 : x1 + (size_t)(r - MG) * 1024;
        rmsnorm_row(xr, gain, dst + (size_t)r * 1024, lane);
    }
}
__device__ void phase_pe_cvt(const float* p0, const float* p1, u16* dst) {
    const size_t n8 = (size_t)MALL * 256 / 8, half = (size_t)MG * 256 / 8;
    for (size_t i = (size_t)blockIdx.x * 512 + ltid(); i < n8; i += (size_t)gridDim.x * 512) {
        const float* s = (i < half) ? p0 + i * 8 : p1 + (i - half) * 8;
        const f32x4 a = *(const f32x4*)s, b = *(const f32x4*)(s + 4);
        u32x4 w; w.x = pk2(a[0], a[1]); w.y = pk2(a[2], a[3]); w.z = pk2(b[0], b[1]); w.w = pk2(b[2], b[3]);
        *(u32x4*)(dst + i * 8) = w;
    }
}

__device__ void conv_unit(const Params& p, int g, int wu, int lane) {
    const int Ng = g ? 2048 : 8192;
    const int quarter = wu & 3, tb = wu >> 2, t0 = tb * 32, n0 = t0 % Ng;
    const u16* raw = (const u16*)((unsigned char*)p.out + OO_SLOT);
    const int cq = quarter * 512 + lane * 8;
    const float* cw = p.in[6];
    float w[5][8];
#pragma unroll
    for (int j = 0; j < 5; ++j) { const f32x4 a = *(const f32x4*)(cw + j * 2048 + cq), b = *(const f32x4*)(cw + j * 2048 + cq + 4);
        w[j][0] = a[0]; w[j][1] = a[1]; w[j][2] = a[2]; w[j][3] = a[3]; w[j][4] = b[0]; w[j][5] = b[1]; w[j][6] = b[2]; w[j][7] = b[3]; }
    float x[5][8];
#pragma unroll
    for (int j = 0; j < 4; ++j) {
        const int n = n0 + j - 2; u32x4 v = {0u, 0u, 0u, 0u};
        if (n >= 0 && n < Ng) v = *(const u32x4*)(raw + (size_t)(t0 + j - 2) * 2048 + cq);
#pragma unroll
        for (int e = 0; e < 4; ++e) { x[j][2 * e] = __uint_as_float(v[e] << 16); x[j][2 * e + 1] = __uint_as_float(v[e] & 0xffff0000u); }
    }
    u16* qn = (u16*)(p.ws + OFF_QN); u16* kn = (u16*)(p.ws + OFF_KN); u16* kT = (u16*)(p.ws + OFF_KT); u16* vf = (u16*)(p.ws + OFF_VF);
#pragma unroll 4
    for (int i = 0; i < 32; ++i) {
        { const int n = n0 + i + 2; u32x4 v = {0u, 0u, 0u, 0u};
          if (n < Ng) v = *(const u32x4*)(raw + (size_t)(t0 + i + 2) * 2048 + cq);
#pragma unroll
          for (int e = 0; e < 4; ++e) { x[4][2 * e] = __uint_as_float(v[e] << 16); x[4][2 * e + 1] = __uint_as_float(v[e] & 0xffff0000u); } }
        float y[8]; float ss = 0.f;
#pragma unroll
        for (int e = 0; e < 8; ++e) { float s = 0.f;
#pragma unroll
            for (int j = 0; j < 5; ++j) s += w[j][e] * x[j][e];
            s = s * sigm(s); y[e] = s; ss += s * s; }
#pragma unroll
        for (int j = 0; j < 4; ++j)
#pragma unroll
            for (int e = 0; e < 8; ++e) x[j][e] = x[j + 1][e];
        const int t = t0 + i, chunk = t >> 6, c = t & 63;
        if (quarter < 2) {
            ss += __shfl_xor(ss, 1); ss += __shfl_xor(ss, 2); ss += __shfl_xor(ss, 4); ss += __shfl_xor(ss, 8);
            float rs = rsqrtf(ss + 1e-6f); if (quarter == 0) rs *= 0.088388347648318440f;
#pragma unroll
            for (int e = 0; e < 8; ++e) y[e] *= rs;
            const int head = lane >> 4, d0 = (lane & 15) * 8;
            const int g16 = d0 >> 4, odd = lane & 1;
            u16* dstp = (quarter == 0 ? qn : kn) + (size_t)t * 512 + head * 128 + g16 * 16 + odd * 4;
            u32x2 lo, hi2; lo.x = pk2(y[0], y[1]); lo.y = pk2(y[2], y[3]); hi2.x = pk2(y[4], y[5]); hi2.y = pk2(y[6], y[7]);
            *(u32x2*)dstp = lo; *(u32x2*)(dstp + 8) = hi2;
            if (quarter == 1) {
                u16* kt = kT + ((size_t)(chunk * 4 + head) * 128 + d0) * 64 + swap23(c);
#pragma unroll
                for (int e = 0; e < 8; ++e) kt[e * 64] = f2bf(y[e]);
            }
        } else {
            const int vhead = (quarter - 2) * 4 + (lane >> 4), dv = (lane & 15) * 8, s = dv >> 5, j0 = dv & 31;
            const int tt = c >> 5, c32 = c & 31, hi = (c32 >> 2) & 1, r = (c32 & 3) | ((c32 >> 3) << 2);
            u16* vp = vf + ((size_t)((chunk * 8 + vhead) * 4 + s)) * 2048 + tt * 1024 + (hi * 32 + j0) * 16 + r;
#pragma unroll
            for (int e = 0; e < 8; ++e) vp[e * 16] = f2bf(y[e]);
        }
    }
}
__device__ void normrope_rows(u16* base, int nrows, int hshift  , const float* gain, int Ng, int gw, int nw, int lane) {
    const int i16 = lane & 15, sub = lane >> 4;
    float gn[8];
    { const f32x4 a = *(const f32x4*)(gain + i16 * 8), b = *(const f32x4*)(gain + i16 * 8 + 4); gn[0] = a[0]; gn[1] = a[1]; gn[2] = a[2]; gn[3] = a[3]; gn[4] = b[0]; gn[5] = b[1]; gn[6] = b[2]; gn[7] = b[3]; }
    const int ax = i16 >> 3, sgn = (i16 >> 2) & 1;
    float inv[8];
#pragma unroll
    for (int e = 0; e < 8; ++e) { const int j = (i16 & 3) * 8 + e; inv[e] = exp2f(-(float)j * (13.287712379549449f / 32.0f)) * 0.15915494309189535f; }
    for (int r4 = gw; r4 < nrows / 4; r4 += nw) {
        const int row = r4 * 4 + sub; const int t = row >> hshift; const int n = t % Ng;
        const float pos = (float)(ax == 0 ? (n >> 6) : (n & 63));
        u16* rp = base + (size_t)row * 128 + i16 * 8;
        const u32x4 v = *(const u32x4*)rp; float y[8]; float ss = 0.f;
#pragma unroll
        for (int e = 0; e < 4; ++e) { y[2 * e] = __uint_as_float(v[e] << 16); y[2 * e + 1] = __uint_as_float(v[e] & 0xffff0000u); }
#pragma unroll
        for (int e = 0; e < 8; ++e) ss += y[e] * y[e];
        ss += __shfl_xor(ss, 1); ss += __shfl_xor(ss, 2); ss += __shfl_xor(ss, 4); ss += __shfl_xor(ss, 8);
        const float rs = rsqrtf(ss * (1.0f / 128.0f) + 1e-6f);
        float o[8];
#pragma unroll
        for (int e = 0; e < 8; ++e) { y[e] = y[e] * rs * gn[e]; }
#pragma unroll
        for (int e = 0; e < 8; ++e) { const float pr = __shfl_xor(y[e], 4); const float rev = pos * inv[e]; const float fr = rev - floorf(rev);
            const float sn = __builtin_amdgcn_sinf(fr), cs = __builtin_amdgcn_cosf(fr);
            o[e] = y[e] * cs + (sgn ? pr : -pr) * sn; }
        u32x4 w; w.x = pk2(o[0], o[1]); w.y = pk2(o[2], o[3]); w.z = pk2(o[4], o[5]); w.w = pk2(o[6], o[7]);
        *(u32x4*)rp = w;
    }
}
__device__ void ba_task(const Params& p, int g, int task, int lane) {
    const int r32 = lane & 31, hi = lane >> 5;
    const u16* u = (const u16*)(p.ws + OFF_U) + (size_t)(g * MG + task * 32 + r32) * 1024 + 8 * hi;
    const u16* wb = (const u16*)(p.ws + OFF_WBA) + (size_t)r32 * 1024 + 8 * hi;
    f32x16 acc = {};
#pragma unroll 8
    for (int ks = 0; ks < 64; ++ks) { const bf16x8 a = *(const bf16x8*)(u + ks * 16), b = *(const bf16x8*)(wb + ks * 16); acc = MFMA32(a, b, acc); }
    float* beta = (float*)(p.ws + OFF_BETA); float* gg = (float*)(p.ws + OFF_G);
    const int n = r32; const bool isb = n < 16; const int nn = n & 15;
    const float al = isb ? 0.f : -__expf(p.in[7][nn]), db = isb ? 0.f : p.in[8][nn];
#pragma unroll
    for (int r = 0; r < 16; ++r) { const int tok = g * MG + task * 32 + crow(r, hi); const float v = acc[r];
        if (isb) beta[(size_t)tok * 16 + nn] = sigm(v);
        else { const float z = v + db; const float sp = fmaxf(z, 0.f) + log1pf(__expf(-fabsf(z))); gg[(size_t)tok * 16 + nn] = al * sp; } }
}
__device__ void phase_g2(const Params& p, int g) {
    const int lane = ltid() & 63, gw = blockIdx.x * 8 + __builtin_amdgcn_readfirstlane(ltid() >> 6), nw = gridDim.x * 8;
    const int Ng = g ? 2048 : 8192;
    for (int wu = gw; wu < 2048; wu += nw) conv_unit(p, g, wu, lane);
    normrope_rows((u16*)((unsigned char*)p.out + OO_ATQ), MG * 8, 3, p.in[11], Ng, gw, nw, lane);
    normrope_rows((u16*)(p.ws + OFF_ATK), MG * 2, 1, p.in[12], Ng, gw, nw, lane);
    for (int task = gw; task < MG / 32; task += nw) ba_task(p, g, task, lane);
}

#define WBAR() do { asm volatile("s_waitcnt lgkmcnt(0)" ::: "memory"); __builtin_amdgcn_wave_barrier(); asm volatile("" ::: "memory"); } while (0)
template <int dir> __device__ __forceinline__ void prep_item(const Params& p, int g, int item, int lane0, float* sA  ) {
    int lane = lane0; asm volatile("" : "+v"(lane));
    const int h = (item >> 1) & 7, cgk = item >> 4, hq = h >> 1;
    const int r32 = lane & 31, hi = lane >> 5;
    float* sg = sA + 4096; float* sb = sg + 64;
    u16* st16 = (u16*)sA;
    const int tokg = g * MG + cgk * 64 + lane;
    const float bet = ((const float*)(p.ws + OFF_BETA))[(size_t)tokg * 16 + dir * 8 + h];
    const float gv = ((const float*)(p.ws + OFF_G))[(size_t)tokg * 16 + dir * 8 + h];
    float gc = gv;
    if (dir == 0) {
#pragma unroll
        for (int o = 1; o < 64; o <<= 1) { const float t = __shfl_up(gc, o); if (lane >= o) gc += t; }
    } else {
#pragma unroll
        for (int o = 1; o < 64; o <<= 1) { const float t = __shfl_down(gc, o); if (lane + o < 64) gc += t; }
    }
    const float gl = __shfl(gc, dir == 0 ? 63 : 0);
    float* aux = (float*)(p.ws + OFF_AUX);
    aux[(size_t)item * 64 + lane] = __expf(gc);
    aux[(size_t)(MiB / 4) + (size_t)item * 64 + lane] = bet;
    aux[(size_t)(2 * MiB / 4) + (size_t)item * 64 + lane] = __expf(gl - gc);
    if (lane == 0) aux[(size_t)(3 * MiB / 4) + item] = __expf(gl);
    sg[lane] = gc; sb[lane] = bet;
    const u16* kn = (const u16*)(p.ws + OFF_KN) + (size_t)(cgk * 64 + r32) * 512 + hq * 128 + 8 * hi;
    const u16* qn = (const u16*)(p.ws + OFF_QN) + (size_t)(cgk * 64 + r32) * 512 + hq * 128 + 8 * hi;
    u32x4* slot = (u32x4*)((unsigned char*)p.out + OO_SLOT + (size_t)item * 16384);
    WBAR();
    {
        f32x16 QK[2][2] = {};
#pragma unroll 2
        for (int ks = 0; ks < 8; ++ks) {
            const bf16x8 k0 = *(const bf16x8*)(kn + ks * 16), k1 = *(const bf16x8*)(kn + 32 * 512 + ks * 16);
            const bf16x8 q0 = *(const bf16x8*)(qn + ks * 16), q1 = *(const bf16x8*)(qn + 32 * 512 + ks * 16);
            QK[0][0] = MFMA32(q0, k0, QK[0][0]); QK[0][1] = MFMA32(q0, k1, QK[0][1]); QK[1][0] = MFMA32(q1, k0, QK[1][0]); QK[1][1] = MFMA32(q1, k1, QK[1][1]);
        }
#pragma unroll
        for (int ti = 0; ti < 2; ++ti)
#pragma unroll
            for (int tj = 0; tj < 2; ++tj) {
                const int j = 32 * tj + r32; const float gj = sg[j];
#pragma unroll
                for (int r = 0; r < 16; ++r) {
                    const int i = 32 * ti + crow(r, hi); const float gi = sg[i];
                    const float dec = __expf(fminf(gi - gj, 0.f));
                    const float mk = fminf(fmaxf((float)(dir == 0 ? i - j : j - i) + 1.0f, 0.f), 1.f);
                    st16[i * 64 + swap23(j)] = f2bf(QK[ti][tj][r] * dec * mk);
                    if ((r & 3) == 3) asm volatile("" ::: "memory");
                }
            }
    }
    WBAR();
#pragma unroll
    for (int it = 0; it < 8; ++it) slot[512 + it * 64 + lane] = ((const u32x4*)st16)[it * 64 + lane];
    WBAR();
    {
        f32x16 KK[2][2] = {};
#pragma unroll 2
        for (int ks = 0; ks < 8; ++ks) {
            const bf16x8 k0 = *(const bf16x8*)(kn + ks * 16), k1 = *(const bf16x8*)(kn + 32 * 512 + ks * 16);
            KK[0][0] = MFMA32(k0, k0, KK[0][0]); KK[0][1] = MFMA32(k0, k1, KK[0][1]); KK[1][0] = MFMA32(k1, k0, KK[1][0]); KK[1][1] = MFMA32(k1, k1, KK[1][1]);
        }
#pragma unroll
        for (int ti = 0; ti < 2; ++ti)
#pragma unroll
            for (int tj = 0; tj < 2; ++tj) {
                const int j = 32 * tj + r32; const float gj = sg[j];
#pragma unroll
                for (int r = 0; r < 16; ++r) {
                    const int i = 32 * ti + crow(r, hi); const float gi = sg[i], bi = sb[i];
                    const float dec = __expf(fminf(gi - gj, 0.f));
                    const float mk = fminf(fmaxf((float)(dir == 0 ? i - j : j - i), 0.f), 1.f);
                    const int ii = dir ? 63 - i : i, jj = dir ? 63 - j : j;
                    sA[ii * 64 + jj] = bi * KK[ti][tj][r] * dec * mk;
                    if ((r & 3) == 3) asm volatile("" ::: "memory");
                }
            }
    }
    WBAR();
    const float fl = (float)lane;
    sA[lane] = fmaxf(1.0f - fl, 0.f);
    WBAR();
#pragma unroll 1
    for (int i = 1; i < 64; ++i) {
        float a0 = fmaxf(1.0f - fabsf(fl - (float)i), 0.f), a1 = 0.f;
        const float* ar = sA + i * 64;
#pragma unroll 1
        for (int j4 = 0; j4 < (i + 3) >> 2; ++j4) {
            const f32x4 av = *(const f32x4*)(ar + 4 * j4);
            const float* xr = sA + (4 * j4) * 64 + lane;
            const int lim = i - 4 * j4;
            a0 -= av[0] * xr[0];
            if (lim > 1) a1 -= av[1] * xr[64];
            if (lim > 2) a0 -= av[2] * xr[128];
            if (lim > 3) a1 -= av[3] * xr[192];
        }
        WBAR();
        sA[i * 64 + lane] = a0 + a1;
        WBAR();
    }
    {
        u16* so = (u16*)slot;
        const int cc = swap23(dir ? 63 - lane : lane);
#pragma unroll 4
        for (int i = 0; i < 64; ++i) { const int ii = dir ? 63 - i : i; so[ii * 64 + cc] = f2bf(sA[i * 64 + lane]); }
    }
    WBAR();
}
__device__ void phase_g3(const Params& p, int g, float* lds) {
    const int lane = ltid() & 63, wv = __builtin_amdgcn_readfirstlane(ltid() >> 6), gw = blockIdx.x * 8 + wv, nw = gridDim.x * 8;
    float* sA = lds + wv * (4096 + 128);
    for (int item0 = gw; item0 < 4096; item0 += nw) { const int item = __builtin_amdgcn_readfirstlane(item0); if (item & 1) prep_item<1>(p, g, item, lane, sA); else prep_item<0>(p, g, item, lane, sA); }
}

__device__ void scan_item(const Params& p, int g, int it) {
    const int Ng = g ? 2048 : 8192, nc = Ng / 64;
    const int b = it >> 3, h = it & 7, hq = h >> 1;
    const int lane = ltid() & 63, wv = __builtin_amdgcn_readfirstlane(ltid() >> 6), dir = wv >> 2, s = wv & 3, r32 = lane & 31, hi = lane >> 5;
    const u16* knb = (const u16*)(p.ws + OFF_KN) + hq * 128 + 8 * hi + (size_t)r32 * 512;
    const u16* qnb = (const u16*)(p.ws + OFF_QN) + hq * 128 + 8 * hi + (size_t)r32 * 512;
    const u16* kTb = (const u16*)(p.ws + OFF_KT) + (size_t)r32 * 64 + 8 * hi;
    const u16* vfb = (const u16*)(p.ws + OFF_VF);
    const float* aux = (const float*)(p.ws + OFF_AUX);
    u16* slots = (u16*)((unsigned char*)p.out + OO_SLOT);
    f32x16 S[4] = {};
    for (int step = 0; step < nc; ++step) {
        const int ci = dir ? nc - 1 - step : step, cgk = b * nc + ci, item = ((cgk * 8 + h) << 1) + dir;
        const u16* kp = knb + (size_t)cgk * 64 * 512; const u16* qp = qnb + (size_t)cgk * 64 * 512;
        const u16* ktp = kTb + (size_t)(cgk * 4 + hq) * 128 * 64;
        u16* slot = slots + (size_t)item * 8192;
        const u16* Tp = slot + (size_t)r32 * 64 + 8 * hi; const u16* Ap = Tp + 4096;
        const float* egp = aux + (size_t)item * 64 + 4 * hi; const float* btp = egp + MiB / 4; const float* ekp = egp + 2 * MiB / 4;
        const float egl = aux[(size_t)(3 * MiB / 4) + item];
        bf16x8 Sb[4][2];
#pragma unroll
        for (int m = 0; m < 4; ++m) { Sb[m][0] = pack8(S[m], 0); Sb[m][1] = pack8(S[m], 8); }
        f32x16 P[2] = {}, Q[2] = {};
#pragma unroll
        for (int t = 0; t < 2; ++t)
#pragma unroll
            for (int m = 0; m < 4; ++m)
#pragma unroll
                for (int sp = 0; sp < 2; ++sp) {
                    const bf16x8 ka = *(const bf16x8*)(kp + (size_t)t * 32 * 512 + 32 * m + 16 * sp);
                    const bf16x8 qa = *(const bf16x8*)(qp + (size_t)t * 32 * 512 + 32 * m + 16 * sp);
                    P[t] = MFMA32(ka, Sb[m][sp], P[t]); Q[t] = MFMA32(qa, Sb[m][sp], Q[t]);
                }
        const u16* vp = vfb + ((size_t)((cgk * 8 + h) * 4 + s)) * 2048 + lane * 16;
        bf16x8 Rb[2][2];
#pragma unroll
        for (int t = 0; t < 2; ++t) {
            const u32x4 v0 = *(const u32x4*)(vp + t * 1024), v1 = *(const u32x4*)(vp + t * 1024 + 8);
            float vv[16];
#pragma unroll
            for (int e = 0; e < 4; ++e) { vv[2 * e] = __uint_as_float(v0[e] << 16); vv[2 * e + 1] = __uint_as_float(v0[e] & 0xffff0000u);
                vv[8 + 2 * e] = __uint_as_float(v1[e] << 16); vv[8 + 2 * e + 1] = __uint_as_float(v1[e] & 0xffff0000u); }
#pragma unroll
            for (int q = 0; q < 4; ++q) { const f32x4 eg = *(const f32x4*)(egp + 32 * t + 8 * q);
                const f32x4 bt = *(const f32x4*)(btp + 32 * t + 8 * q);
#pragma unroll
                for (int e = 0; e < 4; ++e) { const int r = 4 * q + e; P[t][r] = bt[e] * (vv[r] - eg[e] * P[t][r]); } }
            Rb[t][0] = pack8(P[t], 0); Rb[t][1] = pack8(P[t], 8);
        }
        f32x16 Vn[2] = {};
#pragma unroll
        for (int ti = 0; ti < 2; ++ti)
#pragma unroll
            for (int t = 0; t < 2; ++t)
#pragma unroll
                for (int sp = 0; sp < 2; ++sp) { const bf16x8 ta = *(const bf16x8*)(Tp + (size_t)ti * 32 * 64 + 32 * t + 16 * sp); Vn[ti] = MFMA32(ta, Rb[t][sp], Vn[ti]); }
        bf16x8 Vb[2][2];
#pragma unroll
        for (int t = 0; t < 2; ++t) { Vb[t][0] = pack8(Vn[t], 0); Vb[t][1] = pack8(Vn[t], 8); }
#pragma unroll
        for (int ti = 0; ti < 2; ++ti) {
#pragma unroll
            for (int q = 0; q < 4; ++q) { const f32x4 eg = *(const f32x4*)(egp + 32 * ti + 8 * q);
#pragma unroll
                for (int e = 0; e < 4; ++e) Q[ti][4 * q + e] *= eg[e]; }
#pragma unroll
            for (int t = 0; t < 2; ++t)
#pragma unroll
                for (int sp = 0; sp < 2; ++sp) { const bf16x8 aa = *(const bf16x8*)(Ap + (size_t)ti * 32 * 64 + 32 * t + 16 * sp); Q[ti] = MFMA32(aa, Vb[t][sp], Q[ti]); }
        }
#pragma unroll
        for (int t = 0; t < 2; ++t) {
#pragma unroll
            for (int q = 0; q < 4; ++q) { const f32x4 ek = *(const f32x4*)(ekp + 32 * t + 8 * q);
#pragma unroll
                for (int e = 0; e < 4; ++e) Vn[t][4 * q + e] *= ek[e]; }
            Vb[t][0] = pack8(Vn[t], 0); Vb[t][1] = pack8(Vn[t], 8);
        }
#pragma unroll
        for (int m = 0; m < 4; ++m) {
#pragma unroll
            for (int r = 0; r < 16; ++r) S[m][r] *= egl;
#pragma unroll
            for (int t = 0; t < 2; ++t)
#pragma unroll
                for (int sp = 0; sp < 2; ++sp) { const bf16x8 ka = *(const bf16x8*)(ktp + (size_t)m * 32 * 64 + 32 * t + 16 * sp); S[m] = MFMA32(ka, Vb[t][sp], S[m]); }
        }
        asm volatile("s_waitcnt vmcnt(0)" ::: "memory");
        __syncthreads();
#pragma unroll
        for (int ti = 0; ti < 2; ++ti)
#pragma unroll
            for (int r = 0; r < 16; ++r) slot[(size_t)(32 * ti + crow(r, hi)) * 128 + s * 32 + r32] = f2bf(Q[ti][r]);
    }
}
__device__ void phase_g4(const Params& p, int g, unsigned char* lds) {
    const int Ng = g ? 2048 : 8192, Bg = g ? 8 : 2, nscan = Bg * 8, nqb = Ng / 256, natt = Bg * 8 * nqb, total = nscan + natt;
    unsigned* ctr = (unsigned*)(p.ws + OFF_CTR) + g * 64;
    volatile int* sitem = (volatile int*)(lds + 136 * 1024);
    att::bf16* atq = (att::bf16*)((unsigned char*)p.out + OO_ATQ);
    const att::bf16* atk = (const att::bf16*)(p.ws + OFF_ATK); const att::bf16* atv = (const att::bf16*)(p.ws + OFF_ATV);
    for (;;) {
        if (ltid() == 0) *sitem = (int)atomicAdd(ctr, 1u);
        __syncthreads();
        const int it = *sitem;
        __syncthreads();
        if (it >= total) break;
        if (it < nscan) {
#if (G4T & 1) && !(DBG & 512)
            scan_item(p, g, it);
#endif
        } else {
#if G4T & 2
            const int a = it - nscan, qb = a % nqb, h = (a / nqb) & 7, b = a / (nqb * 8);
            const size_t tok = (size_t)b * Ng + (size_t)qb * 256;
            att::bf16* Qb = atq + tok * 1024 + h * 128;
            const size_t kvo = (size_t)b * Ng * 256 + (h >> 2) * 128;
#if DBG & 256
            { u16* q16 = (u16*)Qb; for (int e = ltid(); e < 256 * 16; e += 512) { const int r = e >> 4, c8 = (e & 15) * 8; *(u32x4*)(q16 + (size_t)r * 1024 + c8) = (u32x4){0u, 0u, 0u, 0u}; } }
#elif !(DBG & 128)
            att::attn_dense_body<att::bf16>(Qb, atk + kvo, atv + kvo, Qb, Ng, (char*)lds);
#endif
            __syncthreads();
#endif
        }
    }
}

__device__ void phase_g5(const Params& p, int g) {
    const int lane = ltid() & 63, gw = blockIdx.x * 8 + __builtin_amdgcn_readfirstlane(ltid() >> 6), nw = gridDim.x * 8, i16 = lane & 15, sub = lane >> 4;
    const u16* slots = (const u16*)((unsigned char*)p.out + OO_SLOT); u16* sz = (u16*)((unsigned char*)p.out + OO_SZ);
    float gn[8];
    { const f32x4 a = *(const f32x4*)(p.in[9] + i16 * 8), b = *(const f32x4*)(p.in[9] + i16 * 8 + 4); gn[0] = a[0]; gn[1] = a[1]; gn[2] = a[2]; gn[3] = a[3]; gn[4] = b[0]; gn[5] = b[1]; gn[6] = b[2]; gn[7] = b[3]; }
    for (int r4 = gw; r4 < MG * 8 / 4; r4 += nw) {
        const int row = r4 * 4 + sub, t = row >> 3, h = row & 7, cgk = t >> 6, c = t & 63;
        const u16* of = slots + ((size_t)((cgk * 8 + h) << 1)) * 8192 + c * 128 + i16 * 8;
        const u32x4 a = *(const u32x4*)of, b = *(const u32x4*)(of + 8192);
        u16* zp = sz + (size_t)t * 1024 + h * 128 + i16 * 8; const u32x4 z = *(const u32x4*)zp;
        float y[8]; float ss = 0.f;
#pragma unroll
        for (int e = 0; e < 4; ++e) { y[2 * e] = __uint_as_float(a[e] << 16) + __uint_as_float(b[e] << 16); y[2 * e + 1] = __uint_as_float(a[e] & 0xffff0000u) + __uint_as_float(b[e] & 0xffff0000u); }
#pragma unroll
        for (int e = 0; e < 8; ++e) ss += y[e] * y[e];
        ss += __shfl_xor(ss, 1); ss += __shfl_xor(ss, 2); ss += __shfl_xor(ss, 4); ss += __shfl_xor(ss, 8);
        const float rs = rsqrtf(ss * (1.0f / 128.0f) + 1e-6f);
        float o[8];
#pragma unroll
        for (int e = 0; e < 4; ++e) { o[2 * e] = y[2 * e] * rs * gn[2 * e] * __uint_as_float(z[e] << 16); o[2 * e + 1] = y[2 * e + 1] * rs * gn[2 * e + 1] * __uint_as_float(z[e] & 0xffff0000u); }
        u32x4 w; w.x = pk2(o[0], o[1]); w.y = pk2(o[2], o[3]); w.z = pk2(o[4], o[5]); w.w = pk2(o[6], o[7]);
        *(u32x4*)zp = w;
    }
}

__global__ void __launch_bounds__(512) mega(Params p) {
    extern __shared__ __attribute__((aligned(16))) unsigned char lds[];
    cg::grid_group grid = cg::this_grid();
    unsigned char* ws = p.ws;
    for (int ph = p.ph_lo; ph < p.ph_hi; ++ph) {
        if (ph > p.ph_lo) grid.sync();
#if DBG & 4
        if (ph >= 19) continue;
#endif
#if DBG & 8
        if (ph >= 14 && ph <= 18) continue;
#endif
        if (ph == 0) {
#if PHM & 1
            phase_tconv(p, (float*)lds);
            phase_rmsnorm(p.in[0], p.in[1], p.in[4], (u16*)(ws + OFF_U));
#endif
        } else if (ph <= 12) {
            const int g = (ph - 1) / 6, sp = (ph - 1) % 6;
            if (sp == 1) {
#if PHM & 4
                phase_g2(p, g);
#endif
            } else if (sp == 2) {
#if PHM & 8
                phase_g3(p, g, (float*)lds);
#endif
            } else if (sp == 3) {
#if PHM & 16
                phase_g4(p, g, lds);
#endif
            } else if (sp == 4) {
#if PHM & 32
                phase_g5(p, g);
#endif
            }
        } else if (ph == 14) {
            phase_rmsnorm(p.out, p.out + (size_t)MG * 1024, p.in[15], (u16*)(ws + OFF_U));
        } else if (ph == 19) {
            phase_rmsnorm(p.out, p.out + (size_t)MG * 1024, p.in[18], (u16*)(ws + OFF_U));
            phase_pe_cvt(p.in[2], p.in[3], (u16*)(ws + OFF_PE));
        }
#if PHM & 2
#pragma unroll 1
        for (int k = 0; k < 4; ++k) {
            GDesc d;
            if (!get_desc(p, ph, k, d)) break;
            pg8::Gemm gm; gm.A = d.A; gm.Bt = d.Bt; gm.M = d.M; gm.N = d.N; gm.K = d.K;
            pg8::StaticOrder S; S.init(d.M, d.N, (int)gridDim.x, (int)blockIdx.x);
            pg8::gemm_phase<GEpi, pg8::StaticOrder, false>((PG8_LAS unsigned char*)lds, gm, S, d.e, nullptr);
            __syncthreads();
        }
#endif
    }
}

__global__ void dbg_copy(const float* a, const float* b, float* o) { for (size_t i = (size_t)blockIdx.x * 256 + threadIdx.x; i < (size_t)MALL * 1024; i += (size_t)gridDim.x * 256) o[i] = i < (size_t)MG * 1024 ? a[i] : b[i - (size_t)MG * 1024]; }
#ifndef PH_END
#define PH_END NPHASE
#endif
#ifndef ONE_LAUNCH
#define ONE_LAUNCH 0
#endif
extern "C" void kernel_launch(void* const* d_in, const int* in_sizes, int n_in, void* d_out, int out_size, void* d_ws, size_t ws_size, hipStream_t stream) {
    static int grid = 0;
    if (grid == 0) {
        if (n_in != 21 || ws_size < 256 * MiB) { fprintf(stderr, "kernel_launch: unexpected n_in %d / ws %zu\n", n_in, ws_size); grid = -1; return; }
        if (hipFuncSetAttribute((const void*)mega, hipFuncAttributeMaxDynamicSharedMemorySize, LDS_BYTES) != hipSuccess) { fprintf(stderr, "kernel_launch: hipFuncSetAttribute failed\n"); grid = -1; return; }
        int dev = 0, cus = 0, per_cu = 0;
        hipGetDevice(&dev); hipDeviceGetAttribute(&cus, hipDeviceAttributeMultiprocessorCount, dev);
        hipOccupancyMaxActiveBlocksPerMultiprocessor(&per_cu, (const void*)mega, 512, LDS_BYTES);
        if (per_cu < 1) { fprintf(stderr, "kernel_launch: occupancy query says %d blocks/CU\n", per_cu); per_cu = 1; }
        (void)hipGetLastError();
        grid = cus;
    }
    if (grid < 0) return;
    hipMemsetAsync((unsigned char*)d_ws + OFF_CTR, 0, 4096, stream);
#if DBG & 32
    hipLaunchKernelGGL(dbg_copy, dim3(2048), dim3(256), 0, stream, (const float*)d_in[0], (const float*)d_in[1], (float*)d_out); return;
#endif
    Params p{};
    for (int i = 0; i < 21; ++i) p.in[i] = (const float*)d_in[i];
    p.out = (float*)d_out; p.ws = (unsigned char*)d_ws;
#if ONE_LAUNCH
    p.ph_lo = 0; p.ph_hi = NPHASE;
    void* args[] = {&p};
    hipError_t e = hipLaunchCooperativeKernel((const void*)mega, dim3(grid), dim3(512), args, LDS_BYTES, stream);
    if (e != hipSuccess) fprintf(stderr, "cooperative launch failed: %s (grid %d)\n", hipGetErrorString(e), grid);
#else
    for (int ph = 0; ph < PH_END; ++ph) {
#if DBG & 64
        if (ph == 1) hipMemsetAsync((unsigned char*)d_ws + OFF_MERGED, 0, 64 * MiB, stream);
        if (ph >= 1 && ph <= 12) continue;
#endif
        p.ph_lo = ph; p.ph_hi = ph + 1;
        hipLaunchKernelGGL(mega, dim3(grid), dim3(512), LDS_BYTES, stream, p);
    }
    hipError_t e = hipPeekAtLastError();
    if (e != hipSuccess) fprintf(stderr, "launch failed: %s\n", hipGetErrorString(e));
#endif
}
```

```cpp
#include <hip/hip_runtime.h>
#include <hip/hip_bf16.h>
#include <hip/hip_cooperative_groups.h>
#include <cstdio>
#include <cstdint>
namespace cg = cooperative_groups;
typedef unsigned short u16;
__device__ __forceinline__ int ltid() { int t = (int)threadIdx.x; asm volatile("" : "+v"(t)); return t; }
#ifndef DBG
#define DBG 0
#endif
#ifndef G4T
#define G4T 3
#endif
#ifndef G6T
#define G6T 15
#endif
#ifndef PHM
#define PHM 255
#endif
namespace pg8 {
#define PG8_LAS __attribute__((address_space(3)))
typedef unsigned short bf16_t;
typedef short bf16x8 __attribute__((ext_vector_type(8)));
typedef float f32x4 __attribute__((ext_vector_type(4)));
typedef unsigned u32x4 __attribute__((ext_vector_type(4)));
constexpr int BM = 256, BK = 64, HALF = 128, HTB = HALF * BK * 2  , STAGE_BYTES = 8 * HTB, NXCD = 8, WGM = 8;

__host__ __device__ __forceinline__ int lds_byte(int r, int c) { const int st = (r >> 4) * 2 + (c >> 5), rr = r & 15, cc = c & 31, ob = rr * 64 + cc * 2; return st * 1024 + (ob ^ (((ob >> 9) & 1) << 5)); }
__host__ __device__ __forceinline__ void stage_rc(int b, int& R, int& C) { const int st = b / 1024, sb = b % 1024, swz = sb ^ (((sb >> 9) & 1) << 5); R = (st >> 1) * 16 + swz / 64; C = (st & 1) * 32 + (swz % 64) / 2; }
__host__ __device__ __forceinline__ int perm32(int rho) { const int n = rho >> 4, i = rho & 15; return 8 * (i >> 2) + 4 * n + (i & 3); }

struct Unit { int pm, pn; };
struct Gemm { const bf16_t* A; const bf16_t* Bt; int M, N, K; };

struct StaticOrder {
    int nM, nN, nwg, G, c;
    __host__ __device__ void init(int M, int N, int G_, int c_) { nM = M / BM; nN = N / BM; nwg = nM * nN; G = G_; c = c_; }
    __host__ __device__ bool next(int i, Unit& u) const {
        const long L = (long)i * G + c; if (L >= nwg) return false;
        int wgid = (int)L; { const int q = nwg / NXCD, r = nwg % NXCD, xcd = wgid % NXCD, off = wgid / NXCD; wgid = (xcd < r ? xcd * (q + 1) : r * (q + 1) + (xcd - r) * q) + off; }
        const int nig = WGM * nN, gid = wgid / nig, fm = gid * WGM, gsz = (nM - fm) < WGM ? (nM - fm) : WGM;
        u.pm = fm + ((wgid % nig) % gsz); u.pn = (wgid % nig) / gsz; return true;
    }
    __device__ __forceinline__ void a_ready(const Unit&) const {}
    __device__ __forceinline__ void done(const Unit&) const {}
};
__device__ __forceinline__ unsigned cvt_pk_bf16(float lo, float hi) { unsigned r; asm volatile("v_cvt_pk_bf16_f32 %0, %1, %2" : "=v"(r) : "v"(lo), "v"(hi)); return r; }
typedef float f32x2 __attribute__((ext_vector_type(2)));
template <class Epi, class Sched, bool STAMP = false>
__device__ __forceinline__ void gemm_phase(PG8_LAS unsigned char* lds, const Gemm g, const Sched& S, const Epi& E, unsigned long long* stamps) {
    const int tid = ltid(), wid = __builtin_amdgcn_readfirstlane(tid >> 6), lane = tid & 63, wr = wid >> 2, wc = wid & 3, fr = lane & 15, fq = lane >> 4;
    const int K = g.K, nt = K / BK;
    int ts_lo = 0, ts_hi = 0, nts = 0; const unsigned long long rt_entry = STAMP ? (unsigned long long)wall_clock64() : 0ull;
#define PG8_STAMP() do { if (STAMP && wid == 0 && nts < 64) { const unsigned long long _c = (unsigned long long)clock64(); \
        ts_lo = (lane == nts) ? (int)(unsigned)_c : ts_lo; ts_hi = (lane == nts) ? (int)(unsigned)(_c >> 32) : ts_hi; ++nts; } } while (0)
    PG8_STAMP();
    unsigned voffA[2], voffB[2];
#pragma unroll
    for (int i = 0; i < 2; ++i) { int R, C; stage_rc(tid * 16 + i * 8192, R, C); const int Rb = E.perm ? ((R & ~31) + perm32(R & 31)) : R;
        voffA[i] = (unsigned)(R * K + C) * 2u; voffB[i] = (unsigned)(Rb * K + C) * 2u; }
    const size_t kstep = (size_t)(BK * 2);
    const size_t hstep = (size_t)HALF * K * 2;
    const size_t tstep = 2 * hstep;
    const unsigned ldsw = (unsigned)wid * 1024u;
    const int aoff = lds_byte(wr * 64 + fr, fq * 8), boff = lds_byte(wc * 32 + fr, fq * 8);
#define PG8_SA(b, h) (((b) * 2 + (h)) * HTB)
#define PG8_SB(b, h) ((4 + (b) * 2 + (h)) * HTB)
#define PG8_STAGE(bufoff, gbase, voff) do { _Pragma("unroll") for (int _i = 0; _i < 2; ++_i) \
        __builtin_amdgcn_global_load_lds((const unsigned*)((const char*)(gbase) + (voff)[_i]), (PG8_LAS unsigned*)(lds + (bufoff) + ldsw + _i * 8192), 16, 0, 0); } while (0)
#define PG8_LDA(dst, b, h) do { _Pragma("unroll") for (int m = 0; m < 4; ++m) _Pragma("unroll") for (int k = 0; k < 2; ++k) dst[m][k] = *(const PG8_LAS bf16x8*)(lds + PG8_SA(b, h) + aoff + m * 2048 + k * 1024); } while (0)
#define PG8_LDB(dst, b, h) do { _Pragma("unroll") for (int n = 0; n < 2; ++n) _Pragma("unroll") for (int k = 0; k < 2; ++k) dst[n][k] = *(const PG8_LAS bf16x8*)(lds + PG8_SB(b, h) + boff + n * 2048 + k * 1024); } while (0)
#define PG8_MMA(ai, bj, At, Bt) do { __builtin_amdgcn_s_setprio(1); _Pragma("unroll") for (int m = 0; m < 4; ++m) _Pragma("unroll") for (int n = 0; n < 2; ++n) _Pragma("unroll") for (int k = 0; k < 2; ++k) \
        acc[ai][bj][m][n] = __builtin_amdgcn_mfma_f32_16x16x32_bf16(Bt[n][k], At[m][k], acc[ai][bj][m][n], 0, 0, 0); __builtin_amdgcn_s_setprio(0); } while (0)
#define PG8_WAIT_V(n) asm volatile("s_waitcnt vmcnt(" #n ")" ::: "memory")
#define PG8_WAIT_L(n) asm volatile("s_waitcnt lgkmcnt(" #n ")" ::: "memory")
#define PG8_BAR __builtin_amdgcn_s_barrier()
#define PG8_SCHED __builtin_amdgcn_sched_barrier(0)
    Unit cur, nxt; int ui = 0;
    if (!S.next(0, cur)) return;
    f32x4 acc[2][2][4][2];
#pragma unroll
    for (int a = 0; a < 2; ++a)
#pragma unroll
        for (int b = 0; b < 2; ++b)
#pragma unroll
            for (int m = 0; m < 4; ++m)
#pragma unroll
                for (int n = 0; n < 2; ++n) acc[a][b][m][n] = (f32x4){0.f, 0.f, 0.f, 0.f};
    bf16x8 At[4][2], B0[2][2], B1[2][2];
    const char* cA = (const char*)g.A + (size_t)cur.pm * tstep; const char* cB = (const char*)g.Bt + (size_t)cur.pn * tstep;
    S.a_ready(cur);
    PG8_STAGE(PG8_SB(0, 0), cB, voffB); PG8_STAGE(PG8_SA(0, 0), cA, voffA); PG8_STAGE(PG8_SB(0, 1), cB + hstep, voffB); PG8_STAGE(PG8_SA(0, 1), cA + hstep, voffA);
    if (wr == 1) PG8_BAR;
    PG8_WAIT_V(4); PG8_BAR;
    PG8_STAGE(PG8_SB(1, 0), cB + kstep, voffB); PG8_STAGE(PG8_SA(1, 0), cA + kstep, voffA); PG8_STAGE(PG8_SB(1, 1), cB + hstep + kstep, voffB);
    PG8_WAIT_V(6); PG8_BAR;
    PG8_STAMP();
    for (;;) {
        const bool has_next = S.next(ui + 1, nxt);
        const char* nA = has_next ? (const char*)g.A + (size_t)nxt.pm * tstep : cA; const char* nB = has_next ? (const char*)g.Bt + (size_t)nxt.pn * tstep : cB;
        for (int t = 0; t < nt; t += 2) {
            const bool last = (t == nt - 2);
            const char* a1 = cA + (size_t)(t + 1) * kstep;
            const char* a2 = last ? nA : cA + (size_t)(t + 2) * kstep; const char* b2 = last ? nB : cB + (size_t)(t + 2) * kstep;
            const char* a3 = a2 + kstep; const char* b3 = b2 + kstep;
            if (last && has_next) S.a_ready(nxt);
            PG8_LDB(B0, 0, 0); PG8_SCHED; PG8_LDA(At, 0, 0); PG8_STAGE(PG8_SA(1, 1), a1 + hstep, voffA);
            PG8_WAIT_L(8); PG8_BAR; PG8_WAIT_L(0); PG8_MMA(0, 0, At, B0); PG8_BAR; PG8_SCHED;
            PG8_LDB(B1, 0, 1); PG8_STAGE(PG8_SB(0, 0), b2, voffB);
            PG8_BAR; PG8_WAIT_L(0); PG8_MMA(0, 1, At, B1); PG8_BAR;
            PG8_LDA(At, 0, 1); PG8_STAGE(PG8_SA(0, 0), a2, voffA);
            PG8_BAR; PG8_WAIT_L(0); PG8_MMA(1, 0, At, B0); PG8_BAR; PG8_SCHED;
            PG8_STAGE(PG8_SB(0, 1), b2 + hstep, voffB);
            PG8_WAIT_V(6); PG8_BAR; PG8_MMA(1, 1, At, B1); PG8_BAR;
            PG8_LDB(B0, 1, 0); PG8_SCHED; PG8_LDA(At, 1, 0); PG8_STAGE(PG8_SA(0, 1), a2 + hstep, voffA);
            PG8_WAIT_L(8); PG8_BAR; PG8_WAIT_L(0); PG8_MMA(0, 0, At, B0); PG8_BAR; PG8_SCHED;
            PG8_LDB(B1, 1, 1); PG8_STAGE(PG8_SB(1, 0), b3, voffB);
            PG8_BAR; PG8_WAIT_L(0); PG8_MMA(0, 1, At, B1); PG8_BAR;
            PG8_LDA(At, 1, 1); PG8_STAGE(PG8_SA(1, 0), a3, voffA);
            PG8_BAR; PG8_WAIT_L(0); PG8_MMA(1, 0, At, B0); PG8_BAR; PG8_SCHED;
            PG8_STAGE(PG8_SB(1, 1), b3 + hstep, voffB);
            PG8_WAIT_V(6); PG8_BAR; PG8_MMA(1, 1, At, B1); PG8_BAR;
        }
        PG8_STAMP();
        if constexpr (!Epi::AFTER_DRAIN) { E(acc, cur, wr, wc, fr, fq); S.done(cur); }
        PG8_STAMP();
        if (!has_next) break;
#pragma unroll
        for (int a = 0; a < 2; ++a)
#pragma unroll
            for (int b = 0; b < 2; ++b)
#pragma unroll
                for (int m = 0; m < 4; ++m)
#pragma unroll
                    for (int n = 0; n < 2; ++n) acc[a][b][m][n] = (f32x4){0.f, 0.f, 0.f, 0.f};
        cur = nxt; cA = nA; cB = nB; ++ui;
    }
    PG8_WAIT_V(0);
    if (wr == 0) PG8_BAR;
    PG8_BAR;
    if constexpr (Epi::AFTER_DRAIN) { E.fused(acc, cur, wr, wc, fr, fq, lds, wid, lane); S.done(cur); }
    PG8_STAMP();
    if (STAMP && wid == 0) { stamps[lane] = lane < nts ? (((unsigned long long)(unsigned)ts_hi << 32) | (unsigned)ts_lo) : 0ull;
        if (lane == 62) stamps[62] = rt_entry; if (lane == 63) stamps[63] = (unsigned long long)wall_clock64(); }
#undef PG8_STAMP
#undef PG8_SA
#undef PG8_SB
#undef PG8_STAGE
#undef PG8_LDA
#undef PG8_LDB
#undef PG8_MMA
#undef PG8_WAIT_V
#undef PG8_WAIT_L
#undef PG8_BAR
#undef PG8_SCHED
}
}
namespace att {
using bf16 = __hip_bfloat16;
constexpr int   D = 128, NW = 8, QBLK = 32, KVBLK = 64;
constexpr float SCALE = 0.088388347648318440f;
constexpr float THR = 8.f;
constexpr int SDEPTH = 2;
constexpr int LDQ = 1024, LDK = 256, LDO = 1024;
constexpr size_t SHM_V = KVBLK * D * 2, SHM_K = KVBLK * D * 2, SHM_ATTN = 2 * SHM_V + 2 * SHM_K + NW * 64 * 4;
using bf16x8 = __attribute__((ext_vector_type(8))) short;
using s16x4  = __attribute__((ext_vector_type(4))) short;
using f32x16 = __attribute__((ext_vector_type(16))) float;
using f32x8  = __attribute__((ext_vector_type(8))) float;
using u32x4  = __attribute__((ext_vector_type(4))) unsigned;
#define KSWZ(row, colB) ((row) * 256 + ((colB) ^ (((row) & 7) << 4)))
#define SBAR() __builtin_amdgcn_sched_barrier(0)
__device__ __forceinline__ int crow(int r, int hi) { return (r & 3) + 8 * (r >> 2) + 4 * hi; }
__device__ __forceinline__ unsigned cvtpk(float lo, float hi) {
  unsigned r; asm volatile("v_cvt_pk_bf16_f32 %0, %1, %2" : "=v"(r) : "v"(lo), "v"(hi)); return r;
}
template <typename TIn> struct Stage;
template <> struct Stage<bf16>  { using T = bf16x8;
  __device__ static __forceinline__ T ld8(const bf16* p) { return *reinterpret_cast<const bf16x8*>(p); }
  __device__ static __forceinline__ bf16x8 tobf(T x) { return x; } };
template <> struct Stage<float> { using T = f32x8;
  __device__ static __forceinline__ T ld8(const float* p) { return *reinterpret_cast<const f32x8*>(p); }
  __device__ static __forceinline__ bf16x8 tobf(T x) {
    u32x4 w = {cvtpk(x[0], x[1]), cvtpk(x[2], x[3]), cvtpk(x[4], x[5]), cvtpk(x[6], x[7])}; return *reinterpret_cast<bf16x8*>(&w); } };

__device__ __forceinline__ void partialSM(f32x16& p0, f32x16& p1, float& m_reg, float& mn, float& alpha) {
  constexpr float C = SCALE * 1.4426950408889634f;
  float pmax = p0[0]; for (int r = 1; r < 16; ++r) pmax = fmaxf(pmax, p0[r]); for (int r = 0; r < 16; ++r) pmax = fmaxf(pmax, p1[r]);
  { auto rr = __builtin_amdgcn_permlane32_swap(__float_as_uint(pmax), __float_as_uint(pmax), false, false);
    pmax = fmaxf(__uint_as_float(rr[0]), __uint_as_float(rr[1])); }
  if (__builtin_expect(__all(pmax - m_reg <= THR / SCALE), 1)) { mn = m_reg; alpha = 1.f; }
  else { mn = fmaxf(m_reg, pmax); alpha = __builtin_amdgcn_exp2f((m_reg - mn) * C); m_reg = mn; }
  float mnC = -mn * C;
  for (int r = 0; r < 16; ++r) p0[r] = fmaf(p0[r], C, mnC); for (int r = 0; r < 16; ++r) p1[r] = fmaf(p1[r], C, mnC);
  for (int r = 0; r < 16; ++r) p0[r] = __builtin_amdgcn_exp2f(p0[r]);
}
__device__ __forceinline__ void finishSM(f32x16& p0, f32x16& p1, float alpha, float& l_reg, bf16x8& pa0, bf16x8& pa1, bf16x8& pa2, bf16x8& pa3) {
  for (int r = 0; r < 16; ++r) p1[r] = __builtin_amdgcn_exp2f(p1[r]);
  float ps = 0; for (int r = 0; r < 16; ++r) ps += p0[r]; for (int r = 0; r < 16; ++r) ps += p1[r];
  { auto rr = __builtin_amdgcn_permlane32_swap(__float_as_uint(ps), __float_as_uint(ps), false, false);
    ps = __uint_as_float(rr[0]) + __uint_as_float(rr[1]); }
  l_reg = l_reg * alpha + ps;
#define PK4(P, BASE, OUT) do { unsigned a0 = cvtpk(P[BASE + 0], P[BASE + 1]), a1 = cvtpk(P[BASE + 2], P[BASE + 3]);   \
    unsigned b0 = cvtpk(P[BASE + 4], P[BASE + 5]), b1 = cvtpk(P[BASE + 6], P[BASE + 7]);                              \
    auto r0 = __builtin_amdgcn_permlane32_swap(a0, b0, false, false); auto r1 = __builtin_amdgcn_permlane32_swap(a1, b1, false, false); \
    u32x4 w = {r0[0], r1[0], r0[1], r1[1]}; OUT = *reinterpret_cast<bf16x8*>(&w); } while (0)
  PK4(p0, 0, pa0); PK4(p0, 8, pa1); PK4(p1, 0, pa2); PK4(p1, 8, pa3);
#undef PK4
}
__device__ __forceinline__ void qkt(f32x16& p0, f32x16& p1, const bf16* Ks, const bf16x8* qr, int r32, int hi) {
  p0 = f32x16{}; p1 = f32x16{};
  for (int d0 = 0; d0 < 8; ++d0) { int cb = (d0 * 16 + hi * 8) * 2;
    bf16x8 b0 = *reinterpret_cast<const bf16x8*>((const char*)Ks + KSWZ(r32, cb));
    bf16x8 b1 = *reinterpret_cast<const bf16x8*>((const char*)Ks + KSWZ(32 + r32, cb));
    p0 = __builtin_amdgcn_mfma_f32_32x32x16_bf16(b0, qr[d0], p0, 0, 0, 0);
    p1 = __builtin_amdgcn_mfma_f32_32x32x16_bf16(b1, qr[d0], p1, 0, 0, 0); }
}
__device__ __forceinline__ int v_st(int k, int c) { const int kk = (k & ~0xC) | ((k & 4) << 1) | ((k & 8) >> 1); return ((kk >> 3) * 4 + (c >> 5)) * 512 + ((kk & 7) * 32 + (c & 31)) * 2; }
__device__ __forceinline__ int v_rd_base(int lane) { return ((lane & 3) << 3) | (((lane >> 2) & 3) << 6) | (((lane >> 4) & 1) << 5) | (((lane >> 5) & 1) << 8); }
constexpr int v_rd_off(int d0, int ks, int half) { return d0 * 512 + ks * 4096 + half * 2048; }
template <int OFF> __device__ __forceinline__ s16x4 tr_read(int vb) {
  s16x4 r; asm volatile("ds_read_b64_tr_b16 %0, %1 offset:%2" : "=&v"(r) : "v"(vb), "i"(OFF) : "memory"); return r;
}
template <int D0> __device__ __forceinline__ void pv_one(f32x16& od, int vb, bf16x8 pa0, bf16x8 pa1, bf16x8 pa2, bf16x8 pa3) {
  const s16x4 l0 = tr_read<v_rd_off(D0, 0, 0)>(vb), h0 = tr_read<v_rd_off(D0, 0, 1)>(vb), l1 = tr_read<v_rd_off(D0, 1, 0)>(vb), h1 = tr_read<v_rd_off(D0, 1, 1)>(vb);
  const s16x4 l2 = tr_read<v_rd_off(D0, 2, 0)>(vb), h2 = tr_read<v_rd_off(D0, 2, 1)>(vb), l3 = tr_read<v_rd_off(D0, 3, 0)>(vb), h3 = tr_read<v_rd_off(D0, 3, 1)>(vb);
  asm volatile("s_waitcnt lgkmcnt(0)" ::: "memory"); SBAR();
#define PK(L, H) (bf16x8){L[0], L[1], L[2], L[3], H[0], H[1], H[2], H[3]}
  od = __builtin_amdgcn_mfma_f32_32x32x16_bf16(pa0, PK(l0, h0), od, 0, 0, 0);
  od = __builtin_amdgcn_mfma_f32_32x32x16_bf16(pa1, PK(l1, h1), od, 0, 0, 0);
  od = __builtin_amdgcn_mfma_f32_32x32x16_bf16(pa2, PK(l2, h2), od, 0, 0, 0);
  od = __builtin_amdgcn_mfma_f32_32x32x16_bf16(pa3, PK(l3, h3), od, 0, 0, 0);
#undef PK
}
__device__ __forceinline__ void pv_d0(f32x16* o, int vb, bf16x8 pa0, bf16x8 pa1, bf16x8 pa2, bf16x8 pa3) {
  pv_one<0>(o[0], vb, pa0, pa1, pa2, pa3); pv_one<1>(o[1], vb, pa0, pa1, pa2, pa3); pv_one<2>(o[2], vb, pa0, pa1, pa2, pa3); pv_one<3>(o[3], vb, pa0, pa1, pa2, pa3);
}

template <typename TQ>
__device__ __forceinline__ void attn_dense_body(const TQ* Qb, const bf16* __restrict__ Kh, const bf16* __restrict__ Vh,
                                                bf16* Ob, int seq, char* lds, bool do_store = true, const float* qgain = nullptr, int npos0 = 0) {
  using St = Stage<bf16>; using SQ = Stage<TQ>;
  const int tid = ltid(), wid = tid >> 6, lane = tid & 63, r32 = lane & 31, hi = lane >> 5;
  bf16* V_lds = (bf16*)lds; bf16* K_lds = (bf16*)(lds + 2 * SHM_V);
  float* ws = (float*)(lds + 2 * SHM_V + 2 * SHM_K) + wid * 64; float* li_l = ws; float* al_l = ws + 32;
  float m_reg = -1e30f, l_reg = 0; f32x16 o[4] = {}; bf16x8 qr[8];
  const TQ* Qw = Qb + (long)(wid * QBLK + r32) * LDQ + hi * 8;
#pragma unroll
  for (int d0 = 0; d0 < 8; ++d0) qr[d0] = SQ::tobf(SQ::ld8(Qw + d0 * 16));
  if (qgain) {
    float y[8][8]; float ss = 0.f;
#pragma unroll
    for (int d0 = 0; d0 < 8; ++d0)
#pragma unroll
      for (int e = 0; e < 8; ++e) { const float v = __uint_as_float(((unsigned)(unsigned short)qr[d0][e]) << 16); y[d0][e] = v; ss += v * v; }
    ss += __shfl_xor(ss, 32);
    const float rs = __builtin_amdgcn_rsqf(ss * (1.0f / 128.0f) + 1e-6f);
#pragma unroll
    for (int d0 = 0; d0 < 8; ++d0) { const float4 g0 = *(const float4*)(qgain + d0 * 16 + hi * 8), g1 = *(const float4*)(qgain + d0 * 16 + hi * 8 + 4);
      y[d0][0] *= rs * g0.x; y[d0][1] *= rs * g0.y; y[d0][2] *= rs * g0.z; y[d0][3] *= rs * g0.w; y[d0][4] *= rs * g1.x; y[d0][5] *= rs * g1.y; y[d0][6] *= rs * g1.z; y[d0][7] *= rs * g1.w; }
    const int n = npos0 + wid * QBLK + r32;
#pragma unroll
    for (int ax = 0; ax < 2; ++ax) { const float pos = (float)(ax == 0 ? (n >> 6) : (n & 63));
#pragma unroll
      for (int jb = 0; jb < 2; ++jb)
#pragma unroll
        for (int e = 0; e < 8; ++e) { const int j = 16 * jb + 8 * hi + e;
          const float rev = pos * (__builtin_amdgcn_exp2f(-(float)j * (13.287712379549449f / 32.0f)) * 0.15915494309189535f), fr = rev - floorf(rev);
          const float sn = __builtin_amdgcn_sinf(fr), cs = __builtin_amdgcn_cosf(fr);
          const int dA = 4 * ax + jb, dB = dA + 2;
          const float x1 = y[dA][e], x2 = y[dB][e];
          y[dA][e] = x1 * cs - x2 * sn; y[dB][e] = x2 * cs + x1 * sn; } }
#pragma unroll
    for (int d0 = 0; d0 < 8; ++d0) { u32x4 w = {cvtpk(y[d0][0], y[d0][1]), cvtpk(y[d0][2], y[d0][3]), cvtpk(y[d0][4], y[d0][5]), cvtpk(y[d0][6], y[d0][7])}; qr[d0] = *reinterpret_cast<bf16x8*>(&w); }
  }
  const int sr = tid >> 4, sc = (tid & 15) * 8, vst0 = v_st(sr, sc), vst1 = v_st(32 + sr, sc);
  const int vb0 = (int)(uintptr_t)V_lds + v_rd_base(lane);
  struct { typename St::T vs0, vs1, ks0, ks1; } sr_[SDEPTH];
#define SLOAD(i, k0) do { sr_[i].vs0 = St::ld8(&Vh[(long)((k0) + sr) * LDK + sc]); sr_[i].vs1 = St::ld8(&Vh[(long)((k0) + 32 + sr) * LDK + sc]); \
    sr_[i].ks0 = St::ld8(&Kh[(long)((k0) + sr) * LDK + sc]); sr_[i].ks1 = St::ld8(&Kh[(long)((k0) + 32 + sr) * LDK + sc]); } while (0)
#define SWRITE(b, i) do { *(bf16x8*)((char*)V_lds + (b) * SHM_V + vst0) = St::tobf(sr_[i].vs0);          \
    *(bf16x8*)((char*)V_lds + (b) * SHM_V + vst1) = St::tobf(sr_[i].vs1); int kc = sc * 2;               \
    *(bf16x8*)((char*)K_lds + (b) * SHM_K + KSWZ(sr, kc)) = St::tobf(sr_[i].ks0);                       \
    *(bf16x8*)((char*)K_lds + (b) * SHM_K + KSWZ(32 + sr, kc)) = St::tobf(sr_[i].ks1); } while (0)
#define SWAIT() do { if constexpr (SDEPTH == 2) asm volatile("s_waitcnt vmcnt(4)" ::: "memory"); else asm volatile("s_waitcnt vmcnt(0)" ::: "memory"); } while (0)
#define RESC(a) do { if (__any((a) < 1.f)) { if (hi == 0) al_l[r32] = (a); asm volatile("s_waitcnt lgkmcnt(0)" ::: "memory"); \
    for (int d = 0; d < 4; ++d) for (int r = 0; r < 16; ++r) o[d][r] *= al_l[crow(r, hi)]; } } while (0)
  f32x16 pA0, pA1, pB0, pB1; float mnA, mnB, alA, alB; bf16x8 pa0, pa1, pa2, pa3; const int NT = seq / KVBLK;
  constexpr int SE = 0, SO = SDEPTH - 1;
  SLOAD(SE, 0); asm volatile("s_waitcnt vmcnt(0)" ::: "memory"); SWRITE(0, SE); __syncthreads();
  qkt(pA0, pA1, K_lds, qr, r32, hi); partialSM(pA0, pA1, m_reg, mnA, alA);
  SLOAD(SO, KVBLK); if constexpr (SDEPTH == 2) { if (2 < NT) SLOAD(SE, 2 * KVBLK); }
  SWAIT(); SWRITE(1, SO); __syncthreads();
  for (int j = 1; j + 1 < NT; j += 2) {
    SBAR(); qkt(pB0, pB1, (bf16*)((char*)K_lds + SHM_K), qr, r32, hi);
    finishSM(pA0, pA1, alA, l_reg, pa0, pa1, pa2, pa3); SBAR();
    SLOAD(SO, (j + SDEPTH) * KVBLK); SBAR();
    pv_d0(o, vb0, pa0, pa1, pa2, pa3); partialSM(pB0, pB1, m_reg, mnB, alB);
    __syncthreads(); SWAIT(); SWRITE(0, SE);
    RESC(alB); __syncthreads();
    SBAR(); qkt(pA0, pA1, K_lds, qr, r32, hi);
    finishSM(pB0, pB1, alB, l_reg, pa0, pa1, pa2, pa3); SBAR();
    if (SDEPTH == 1 || j + 3 < NT) SLOAD(SE, (j + 1 + SDEPTH) * KVBLK); SBAR();
    pv_d0(o, vb0 + (int)SHM_V, pa0, pa1, pa2, pa3); partialSM(pA0, pA1, m_reg, mnA, alA);
    __syncthreads(); SWAIT(); SWRITE(1, SO);
    RESC(alA); __syncthreads();
  }
  SBAR(); qkt(pB0, pB1, (bf16*)((char*)K_lds + SHM_K), qr, r32, hi);
  finishSM(pA0, pA1, alA, l_reg, pa0, pa1, pa2, pa3); SBAR();
  pv_d0(o, vb0, pa0, pa1, pa2, pa3); partialSM(pB0, pB1, m_reg, mnB, alB);
  __syncthreads(); RESC(alB);
  finishSM(pB0, pB1, alB, l_reg, pa0, pa1, pa2, pa3); SBAR();
  pv_d0(o, vb0 + (int)SHM_V, pa0, pa1, pa2, pa3);
  if (hi == 0) li_l[r32] = l_reg; asm volatile("s_waitcnt lgkmcnt(0)" ::: "memory");
  float rli[16];
#pragma unroll
  for (int r = 0; r < 16; ++r) rli[r] = __builtin_amdgcn_rcpf(li_l[crow(r, hi)]);
  bf16* Ow = Ob + (long)(wid * QBLK) * LDO;
#pragma unroll
  for (int r = 0; r < 16; ++r) { int orow = crow(r, hi); if (!do_store) continue;
    for (int d0 = 0; d0 < 4; ++d0) Ow[(long)orow * LDO + d0 * 32 + r32] = __float2bfloat16(o[d0][r] * rli[r]); }
#undef SLOAD
#undef SWRITE
#undef SWAIT
#undef RESC
}
}
typedef short bf16x8 __attribute__((ext_vector_type(8)));
typedef float f32x4 __attribute__((ext_vector_type(4)));
typedef float f32x16 __attribute__((ext_vector_type(16)));
typedef unsigned u32x4 __attribute__((ext_vector_type(4)));
typedef unsigned u32x2 __attribute__((ext_vector_type(2)));
constexpr size_t MiB = 1ull << 20;
constexpr int MALL = 32768, MG = 16384;
constexpr size_t OFF_WIN = 0, OFF_WBA = 13 * MiB, OFF_WDN = 14 * MiB, OFF_WAT = 16 * MiB, OFF_WO = 18 * MiB, OFF_WUP = 20 * MiB, OFF_WDA = 28 * MiB, OFF_WDB = 32 * MiB,
                 OFF_WPG = 36 * MiB, OFF_WPLE = 38 * MiB, OFF_U = 39 * MiB, OFF_MERGED = 103 * MiB, OFF_ATK = 135 * MiB, OFF_ATV = 143 * MiB, OFF_QN = 167 * MiB,
                 OFF_KN = 183 * MiB, OFF_KT = 199 * MiB, OFF_VF = 215 * MiB, OFF_BETA = 247 * MiB, OFF_G = 249 * MiB, OFF_AUX = 251 * MiB, OFF_CTR = 255 * MiB,
                 OFF_HM = 103 * MiB, OFF_PE = 231 * MiB, OFF_GBUF = 103 * MiB;
constexpr size_t OO_SLOT = 0, OO_ATQ = 64 * MiB, OO_SZ = 96 * MiB, OO_BUFA = 0, OO_BUFB = 32 * MiB;
constexpr int LDS_BYTES = 136 * 1024 + 64;
constexpr int NPHASE = 21;

struct Params { const float* in[21]; float* out; unsigned char* ws; int ph_lo, ph_hi; };

__device__ __forceinline__ float bf2f(u16 b) { return __uint_as_float(((unsigned)b) << 16); }
__device__ __forceinline__ u16 f2bf(float f) { unsigned u = __float_as_uint(f); u += 0x7FFFu + ((u >> 16) & 1u); return (u16)(u >> 16); }
typedef __bf16 bf16x2_t __attribute__((ext_vector_type(2)));
typedef float f32x2_t __attribute__((ext_vector_type(2)));
__device__ __forceinline__ unsigned pk2(float lo, float hi) { f32x2_t f = {lo, hi}; bf16x2_t b = __builtin_convertvector(f, bf16x2_t); return __builtin_bit_cast(unsigned, b); }
__device__ __forceinline__ float sigm(float x) { return __builtin_amdgcn_rcpf(1.0f + __builtin_amdgcn_exp2f(x * -1.4426950408889634f)); }
__device__ __forceinline__ int swap23(int j) { return (j & ~0xC) | ((j & 4) << 1) | ((j & 8) >> 1); }
__device__ __forceinline__ int crow(int r, int hi) { return (r & 3) + 8 * (r >> 2) + 4 * hi; }
__device__ __forceinline__ bf16x8 pack8(const f32x16& v, int base) {
    u32x4 w = {pk2(v[base], v[base + 1]), pk2(v[base + 2], v[base + 3]), pk2(v[base + 4], v[base + 5]), pk2(v[base + 6], v[base + 7])};
    return *reinterpret_cast<bf16x8*>(&w);
}
#define MFMA32(a, b, c) __builtin_amdgcn_mfma_f32_32x32x16_bf16(a, b, c, 0, 0, 0)

enum { E_IN = 0, E_SIG, E_MULRMW, E_MERGE, E_RELU2, E_RES, E_ACC, E_SIG4, E_PLE };
struct GEpi {
    static constexpr bool AFTER_DRAIN = false;
    int mode, perm, ld, pad; u16 *o1, *o2, *o3, *o4, *o5; float* C; const float *r0, *r1;
    __device__ __forceinline__ void operator()(const pg8::f32x4 (&acc)[2][2][4][2], const pg8::Unit& u, int wr, int wc, int fr, int fq) const {
        using namespace pg8;
        const int row0 = u.pm * BM + wr * 64 + fr;
        if (perm) {
            u16* base = o1; u16* dst = o1; int ldd = ld; int colt = u.pn * BM; bool act = false;
            if (mode == E_IN) {
                if (u.pn < 8) { base = o1; ldd = 2048; colt = u.pn * 256; }
                else if (u.pn < 12) { base = o2; ldd = 1024; colt = (u.pn - 8) * 256; }
                else if (u.pn == 12) { base = o3; ldd = 256; colt = 0; }
                else if (u.pn == 13) { base = o4; ldd = 256; colt = 0; }
                else { base = o5; ldd = 1024; colt = (u.pn - 14) * 256; act = true; }
                dst = base;
            }
            if (mode == E_MERGE) dst = o3;
            const int col0 = colt + wc * 32 + 8 * fq;
#pragma unroll
            for (int ai = 0; ai < 2; ++ai)
#pragma unroll
                for (int m = 0; m < 4; ++m) {
                    const size_t roff = (size_t)(row0 + ai * HALF + m * 16) * ldd + col0;
#pragma unroll
                    for (int bj = 0; bj < 2; ++bj) {
                        f32x4 v0 = acc[ai][bj][m][0], v1 = acc[ai][bj][m][1];
                        float v[8] = {v0[0], v0[1], v0[2], v0[3], v1[0], v1[1], v1[2], v1[3]};
                        if (mode == E_IN) { if (act) {
#pragma unroll
                            for (int j = 0; j < 8; ++j) v[j] = v[j] * sigm(v[j]); } }
                        else if (mode == E_SIG) {
#pragma unroll
                            for (int j = 0; j < 8; ++j) v[j] = sigm(v[j]); }
                        else if (mode == E_RELU2) {
#pragma unroll
                            for (int j = 0; j < 8; ++j) { float t = fmaxf(v[j], 0.f); v[j] = t * t; } }
                        else if (mode == E_MULRMW) {
                            const u32x4 g = *(const u32x4*)(o1 + roff + bj * HALF);
#pragma unroll
                            for (int j = 0; j < 4; ++j) { v[2 * j] *= __uint_as_float(g[j] << 16); v[2 * j + 1] *= __uint_as_float(g[j] & 0xffff0000u); } }
                        else {
                            const u32x4 a = *(const u32x4*)(o1 + roff + bj * HALF); const u32x4 g = *(const u32x4*)(o2 + roff + bj * HALF);
#pragma unroll
                            for (int j = 0; j < 4; ++j) { v[2 * j] = __uint_as_float(a[j] << 16) + v[2 * j] * __uint_as_float(g[j] << 16);
                                v[2 * j + 1] = __uint_as_float(a[j] & 0xffff0000u) + v[2 * j + 1] * __uint_as_float(g[j] & 0xffff0000u); } }
#if DBG & 1
                        if (mode == E_MERGE) {
#pragma unroll
                            for (int j = 0; j < 8; ++j) v[j] = 0.f; }
#endif
#if DBG & 2
                        if (mode == E_MULRMW) {
#pragma unroll
                            for (int j = 0; j < 8; ++j) v[j] = 0.f; }
#endif
                        u32x4 w; w.x = pk2(v[0], v[1]); w.y = pk2(v[2], v[3]); w.z = pk2(v[4], v[5]); w.w = pk2(v[6], v[7]);
                        *(u32x4*)(dst + roff + bj * HALF) = w;
                    }
                    asm volatile("" ::: "memory");
                }
        } else {
            const int col0 = u.pn * BM + wc * 32 + 4 * fq;
#pragma unroll
            for (int ai = 0; ai < 2; ++ai)
#pragma unroll
                for (int m = 0; m < 4; ++m) {
                    const int row = row0 + ai * HALF + m * 16;
                    const size_t roff = (size_t)row * ld + col0;
                    const float* rp = (row < MG) ? (r0 + (size_t)row * ld) : (r1 + (size_t)(row - MG) * ld);
#pragma unroll
                    for (int bj = 0; bj < 2; ++bj)
#pragma unroll
                        for (int n = 0; n < 2; ++n) {
                            const size_t off = roff + bj * HALF + n * 16; f32x4 a = acc[ai][bj][m][n];
                            if (mode == E_RES) { const f32x4 x = *(const f32x4*)(rp + col0 + bj * HALF + n * 16); *(f32x4*)(C + off) = x + a; }
                            else if (mode == E_ACC) { const f32x4 x = *(const f32x4*)(C + off); *(f32x4*)(C + off) = x + a; }
                            else if (mode == E_SIG4) { u32x2 w; w.x = pk2(sigm(a[0]), sigm(a[1])); w.y = pk2(sigm(a[2]), sigm(a[3])); *(u32x2*)(o1 + off) = w; }
                            else { const u32x2 g = *(const u32x2*)(o1 + off); const f32x4 x = *(const f32x4*)(C + off);
                                f32x4 o; o[0] = x[0] + __uint_as_float(g.x << 16) * a[0]; o[1] = x[1] + __uint_as_float(g.x & 0xffff0000u) * a[1];
                                o[2] = x[2] + __uint_as_float(g.y << 16) * a[2]; o[3] = x[3] + __uint_as_float(g.y & 0xffff0000u) * a[3]; *(f32x4*)(C + off) = o; }
                        }
                    asm volatile("" ::: "memory");
                }
        }
    }
};
struct GDesc { const u16* A; const u16* Bt; int M, N, K; GEpi e; };
__device__ __forceinline__ bool get_desc(const Params& p, int ph, int k, GDesc& d) {
    unsigned char* ws = p.ws; unsigned char* O = (unsigned char*)p.out;
    d.e = GEpi{}; d.e.perm = 1; d.e.ld = 1024; d.M = MALL; d.N = 1024; d.K = 1024;
    if (ph >= 1 && ph <= 12) {
        const int g = (ph - 1) / 6, sp = (ph - 1) % 6;
        const u16* ug = (const u16*)(ws + OFF_U) + (size_t)g * MG * 1024;
        d.M = MG;
        if (sp == 0) { if (k > 0) return false;
            d.A = ug; d.Bt = (const u16*)(ws + OFF_WIN); d.N = 4608; d.e.mode = E_IN;
            d.e.o1 = (u16*)(O + OO_SLOT); d.e.o2 = (u16*)(O + OO_ATQ); d.e.o3 = (u16*)(ws + OFF_ATK); d.e.o4 = (u16*)(ws + OFF_ATV); d.e.o5 = (u16*)(O + OO_SZ); return true; }
        if (sp != 5 || k > 3) return false;
        u16* bufA = (u16*)(O + OO_BUFA); u16* bufB = (u16*)(O + OO_BUFB); u16* merged = (u16*)(ws + OFF_MERGED) + (size_t)g * MG * 1024;
        if (k == 0) { d.A = ug; d.Bt = (const u16*)(ws + OFF_WIN) + (size_t)4608 * 1024; d.e.mode = E_SIG; d.e.o1 = bufA; }
        else if (k == 1) { d.A = (const u16*)(O + OO_SZ); d.Bt = (const u16*)(ws + OFF_WDN); d.e.mode = E_MULRMW; d.e.o1 = bufA; }
        else if (k == 2) { d.A = ug; d.Bt = (const u16*)(ws + OFF_WIN) + (size_t)5632 * 1024; d.e.mode = E_SIG; d.e.o1 = bufB; }
        else { d.A = (const u16*)(O + OO_ATQ); d.Bt = (const u16*)(ws + OFF_WAT); d.e.mode = E_MERGE; d.e.o1 = bufA; d.e.o2 = bufB; d.e.o3 = merged; }
        return true;
    }
    if (ph == 13) { if (k > 0) return false; d.A = (const u16*)(ws + OFF_MERGED); d.Bt = (const u16*)(ws + OFF_WO); d.e.mode = E_RES; d.e.perm = 0; d.e.C = p.out; d.e.r0 = p.in[0]; d.e.r1 = p.in[1]; return true; }
    if (ph == 15 || ph == 17) { if (k > 1) return false; d.A = (const u16*)(ws + OFF_U); d.Bt = (const u16*)(ws + OFF_WUP) + (ph == 17 ? (size_t)2048 * 1024 : 0) + (size_t)k * 1024 * 1024; d.N = 1024; d.e.mode = E_RELU2; d.e.o1 = (u16*)(ws + OFF_HM) + k * 1024; d.e.ld = 2048; return true; }
    if (ph == 16 || ph == 18) { if (k > 0) return false; d.A = (const u16*)(ws + OFF_HM); d.Bt = (const u16*)(ws + (ph == 16 ? OFF_WDA : OFF_WDB)); d.K = 2048; d.e.mode = E_ACC; d.e.perm = 0; d.e.C = p.out; return true; }
    if (ph == 20) { if (k > 1) return false;
        if (k == 0) { d.A = (const u16*)(ws + OFF_U); d.Bt = (const u16*)(ws + OFF_WPG); d.e.mode = E_SIG4; d.e.perm = 0; d.e.o1 = (u16*)(ws + OFF_GBUF); }
        else { d.A = (const u16*)(ws + OFF_PE); d.Bt = (const u16*)(ws + OFF_WPLE); d.K = 256; d.e.mode = E_PLE; d.e.perm = 0; d.e.o1 = (u16*)(ws + OFF_GBUF); d.e.C = p.out; }
        return true; }
    return false;
}

__device__ __forceinline__ void tconv_unit(const float* __restrict__ src, int ld, int col0, int ncols, int K, u16* __restrict__ dst, int unit, float* tile) {
    const int nK = K / 64, kt = unit % nK, nt2 = unit / nK, k0 = kt * 64, n0 = nt2 * 128, tid = ltid(), a = tid & 63, b = tid >> 6;
    const int a4 = tid & 31, kk = tid >> 5, nl = 4 * a4, hh = nl >> 6, al = nl & 63;
#pragma unroll
    for (int i = 0; i < 4; ++i) { const int k = kk + 16 * i, n = n0 + nl;
        f32x4 v = {0.f, 0.f, 0.f, 0.f};
        if (n < ncols) v = *(const f32x4*)(src + (size_t)(k0 + k) * ld + col0 + n);
        float* tp = tile + hh * 4160 + k * 65 + al; tp[0] = v[0]; tp[1] = v[1]; tp[2] = v[2]; tp[3] = v[3]; }
    __syncthreads();
#pragma unroll
    for (int h = 0; h < 2; ++h)
#pragma unroll
        for (int i = 0; i < 8; ++i) { const int nn = b + 8 * i; if (n0 + 64 * h + nn < ncols) dst[(size_t)(n0 + 64 * h + nn) * K + k0 + a] = f2bf(tile[h * 4160 + a * 65 + nn]); }
    __syncthreads();
}
__device__ void phase_tconv(const Params& p, float* tile) {
    u16* ws = (u16*)p.ws;
    constexpr int NJ = 13;
    const int cum[NJ + 1] = {0, 256, 448, 576, 832, 848, 976, 1104, 1232, 1744, 2000, 2256, 2384, 2416};
    for (int uu = blockIdx.x; uu < 2416; uu += gridDim.x) {
        int j = 0;
#pragma unroll
        for (int q = 1; q < NJ; ++q) if (uu >= cum[q]) j = q;
        const int unit = uu - cum[j];
        const float* src; int ld, col0, ncols, K; size_t doff;
        switch (j) {
            case 0: src = p.in[5]; ld = 6688; col0 = 0; ncols = 2048; K = 1024; doff = OFF_WIN; break;
            case 1: src = p.in[5]; ld = 6688; col0 = 3104; ncols = 1536; K = 1024; doff = OFF_WIN + (size_t)2048 * 2048; break;
            case 2: src = p.in[5]; ld = 6688; col0 = 2048; ncols = 1024; K = 1024; doff = OFF_WIN + (size_t)3584 * 2048; break;
            case 3: src = p.in[5]; ld = 6688; col0 = 4640; ncols = 2048; K = 1024; doff = OFF_WIN + (size_t)4608 * 2048; break;
            case 4: src = p.in[5]; ld = 6688; col0 = 3072; ncols = 32; K = 1024; doff = OFF_WBA; break;
            case 5: src = p.in[10]; ld = 1024; col0 = 0; ncols = 1024; K = 1024; doff = OFF_WDN; break;
            case 6: src = p.in[13]; ld = 1024; col0 = 0; ncols = 1024; K = 1024; doff = OFF_WAT; break;
            case 7: src = p.in[14]; ld = 1024; col0 = 0; ncols = 1024; K = 1024; doff = OFF_WO; break;
            case 8: src = p.in[16]; ld = 4096; col0 = 0; ncols = 4096; K = 1024; doff = OFF_WUP; break;
            case 9: src = p.in[17]; ld = 1024; col0 = 0; ncols = 1024; K = 2048; doff = OFF_WDA; break;
            case 10: src = p.in[17] + (size_t)2048 * 1024; ld = 1024; col0 = 0; ncols = 1024; K = 2048; doff = OFF_WDB; break;
            case 11: src = p.in[19]; ld = 1024; col0 = 0; ncols = 1024; K = 1024; doff = OFF_WPG; break;
            default: src = p.in[20]; ld = 1024; col0 = 0; ncols = 1024; K = 256; doff = OFF_WPLE; break;
        }
        tconv_unit(src, ld, col0, ncols, K, (u16*)(p.ws + doff), unit, tile);
    }
    (void)ws;
}
__device__ void phase_rmsnorm(const float* x0, const float* x1, const float* gain, u16* dst) {
    const int lane = ltid() & 63, gw = blockIdx.x * 8 + __builtin_amdgcn_readfirstlane(ltid() >> 6), nw = gridDim.x * 8;
    f32x4 g4[4];
#pragma unroll
    for (int i = 0; i < 4; ++i) g4[i] = *(const f32x4*)(gain + i * 256 + lane * 4);
    f32x4 nx[4];
    { const float* xr = (gw < MG) ? x0 + (size_t)gw * 1024 : x1 + (size_t)(gw - MG) * 1024;
#pragma unroll
      for (int i = 0; i < 4; ++i) nx[i] = *(const f32x4*)(xr + i * 256 + lane * 4); }
    for (int r = gw; r < MALL; r += nw) {
        f32x4 v[4]; float ss = 0.f;
#pragma unroll
        for (int i = 0; i < 4; ++i) v[i] = nx[i];
        const int rn = r + nw;
        if (rn < MALL) { const float* xr = (rn < MG) ? x0 + (size_t)rn * 1024 : x1 + (size_t)(rn - MG) * 1024;
#pragma unroll
            for (int i = 0; i < 4; ++i) nx[i] = *(const f32x4*)(xr + i * 256 + lane * 4); }
#pragma unroll
        for (int i = 0; i < 4; ++i) ss += v[i][0] * v[i][0] + v[i][1] * v[i][1] + v[i][2] * v[i][2] + v[i][3] * v[i][3];
#pragma unroll
        for (int o = 32; o >= 1; o >>= 1) ss += __shfl_xor(ss, o);
        const float rs = rsqrtf(ss * (1.0f / 1024.0f) + 1e-6f);
        u16* d = dst + (size_t)r * 1024;
#pragma unroll
        for (int i = 0; i < 4; ++i) { u32x2 w; w.x = pk2(v[i][0] * rs * g4[i][0], v[i][1] * rs * g4[i][1]); w.y = pk2(v[i][2] * rs * g4[i][2], v[i][3] * rs * g4[i][3]);
            *(u32x2*)(d + i * 256 + lane * 4) = w; }
    }
}
__device__ void phase_pe_cvt(const float* p0, const float* p1, u16* dst) {
    const size_t n8 = (size_t)MALL * 256 / 8, half = (size_t)MG * 256 / 8;
    for (size_t i = (size_t)blockIdx.x * 512 + ltid(); i < n8; i += (size_t)gridDim.x * 512) {
        const float* s = (i < half) ? p0 + i * 8 : p1 + (i - half) * 8;
        const f32x4 a = *(const f32x4*)s, b = *(const f32x4*)(s + 4);
        u32x4 w; w.x = pk2(a[0], a[1]); w.y = pk2(a[2], a[3]); w.z = pk2(b[0], b[1]); w.w = pk2(b[2], b[3]);
        *(u32x4*)(dst + i * 8) = w;
    }
}

__device__ void conv_unit(const Params& p, int g, int wu, int lane) {
    const int Ng = g ? 2048 : 8192;
    const int quarter = wu & 3, tb = wu >> 2, t0 = tb * 32, n0 = t0 % Ng;
    const u16* raw = (const u16*)((unsigned char*)p.out + OO_SLOT);
    const int cq = quarter * 512 + lane * 8;
    const float* cw = p.in[6];
    float w[5][8];
#pragma unroll
    for (int j = 0; j < 5; ++j) { const f32x4 a = *(const f32x4*)(cw + j * 2048 + cq), b = *(const f32x4*)(cw + j * 2048 + cq + 4);
        w[j][0] = a[0]; w[j][1] = a[1]; w[j][2] = a[2]; w[j][3] = a[3]; w[j][4] = b[0]; w[j][5] = b[1]; w[j][6] = b[2]; w[j][7] = b[3]; }
    u32x4 xr[5];
#pragma unroll
    for (int j = 0; j < 4; ++j) {
        const int n = n0 + j - 2; xr[j] = (u32x4){0u, 0u, 0u, 0u};
        if (n >= 0 && n < Ng) xr[j] = *(const u32x4*)(raw + (size_t)(t0 + j - 2) * 2048 + cq);
    }
    u16* qn = (u16*)(p.ws + OFF_QN); u16* kn = (u16*)(p.ws + OFF_KN); u16* kT = (u16*)(p.ws + OFF_KT); u16* vf = (u16*)(p.ws + OFF_VF);
    unsigned ybp[8][8];
#pragma unroll 1
    for (int h16 = 0; h16 < 2; ++h16) {
#pragma unroll
        for (int q4 = 0; q4 < 4; ++q4) {
            const int i4 = h16 * 4 + q4;
            float ylo[8];
            u32x4 vcu[4];
#pragma unroll
            for (int k4 = 0; k4 < 4; ++k4) { const int i = 4 * i4 + k4; const int n = n0 + i + 2; vcu[k4] = (u32x4){0u, 0u, 0u, 0u}; if (n < Ng) vcu[k4] = *(const u32x4*)(raw + (size_t)(t0 + i + 2) * 2048 + cq); }
#pragma unroll
            for (int k4 = 0; k4 < 4; ++k4) {
                const int i = 4 * i4 + k4;
                xr[4] = vcu[k4];
                float y[8]; float ss = 0.f;
#pragma unroll
                for (int e = 0; e < 8; ++e) { float sm = 0.f;
#pragma unroll
                    for (int j = 0; j < 5; ++j) { const unsigned wd = xr[j][e >> 1]; sm += w[j][e] * __uint_as_float((e & 1) ? (wd & 0xffff0000u) : (wd << 16)); }
                    sm = sm * sigm(sm); y[e] = sm; ss += sm * sm; }
#pragma unroll
                for (int j = 0; j < 4; ++j) xr[j] = xr[j + 1];
                const int t = t0 + i;
                if (quarter < 2) {
                    ss += __shfl_xor(ss, 1); ss += __shfl_xor(ss, 2); ss += __shfl_xor(ss, 4); ss += __shfl_xor(ss, 8);
                    float rs = rsqrtf(ss + 1e-6f); if (quarter == 0) rs *= 0.088388347648318440f;
#pragma unroll
                    for (int e = 0; e < 8; ++e) y[e] *= rs;
                    const int head = lane >> 4, d0 = (lane & 15) * 8, g16 = d0 >> 4, odd = lane & 1;
                    u16* dstp = (quarter == 0 ? qn : kn) + (size_t)t * 512 + head * 128 + g16 * 16 + odd * 4;
                    u32x2 lo, hi2; lo.x = pk2(y[0], y[1]); lo.y = pk2(y[2], y[3]); hi2.x = pk2(y[4], y[5]); hi2.y = pk2(y[6], y[7]);
                    *(u32x2*)dstp = lo; *(u32x2*)(dstp + 8) = hi2;
                }
#pragma unroll
                for (int e = 0; e < 8; ++e) { if ((k4 & 1) == 0) ylo[e] = y[e]; else ybp[2 * q4 + (k4 >> 1)][e] = pk2(ylo[e], y[e]); }
            }
        }
        const int tq = t0 + 16 * h16, chunk = tq >> 6, c0 = tq & 63;
        if (quarter == 1) {
            const int head = lane >> 4, d0 = (lane & 15) * 8;
            u16* kt = kT + ((size_t)(chunk * 4 + head) * 128 + d0) * 64 + c0;
#pragma unroll
            for (int e = 0; e < 8; ++e) {
                u32x4 w0, w1;
                w0.x = ybp[0][e]; w0.y = ybp[1][e];
                w0.z = ybp[4][e]; w0.w = ybp[5][e];
                w1.x = ybp[2][e]; w1.y = ybp[3][e];
                w1.z = ybp[6][e]; w1.w = ybp[7][e];
                *(u32x4*)(kt + e * 64) = w0; *(u32x4*)(kt + e * 64 + 8) = w1; }
        } else if (quarter >= 2) {
            const int vhead = (quarter - 2) * 4 + (lane >> 4), dv = (lane & 15) * 8, sl = dv >> 5, j0 = dv & 31;
            const int tt = c0 >> 5, rb = ((c0 >> 4) & 1) * 8;
            u16* vp = vf + ((size_t)((chunk * 8 + vhead) * 4 + sl)) * 2048 + tt * 1024 + j0 * 16 + rb;
#pragma unroll
            for (int e = 0; e < 8; ++e) {
                u32x4 w0, w1;
                w0.x = ybp[0][e]; w0.y = ybp[1][e];
                w0.z = ybp[4][e]; w0.w = ybp[5][e];
                w1.x = ybp[2][e]; w1.y = ybp[3][e];
                w1.z = ybp[6][e]; w1.w = ybp[7][e];
                *(u32x4*)(vp + e * 16) = w0; *(u32x4*)(vp + e * 16 + 32 * 16) = w1; }
        }
    }
}
__device__ void normrope_rows(u16* base, int nrows, int hshift  , const float* gain, int Ng, int gw, int nw, int lane) {
    const int i16 = lane & 15, sub = lane >> 4;
    float gn[8];
    { const f32x4 a = *(const f32x4*)(gain + i16 * 8), b = *(const f32x4*)(gain + i16 * 8 + 4); gn[0] = a[0]; gn[1] = a[1]; gn[2] = a[2]; gn[3] = a[3]; gn[4] = b[0]; gn[5] = b[1]; gn[6] = b[2]; gn[7] = b[3]; }
    const int ax = i16 >> 3, sgn = (i16 >> 2) & 1;
    float inv[8];
#pragma unroll
    for (int e = 0; e < 8; ++e) { const int j = (i16 & 3) * 8 + e; inv[e] = exp2f(-(float)j * (13.287712379549449f / 32.0f)) * 0.15915494309189535f; }
    u32x4 nv = {0u, 0u, 0u, 0u};
    if (gw < nrows / 4) nv = *(const u32x4*)(base + (size_t)(gw * 4 + sub) * 128 + i16 * 8);
    for (int r4 = gw; r4 < nrows / 4; r4 += nw) {
        const int row = r4 * 4 + sub; const int t = row >> hshift; const int n = t % Ng;
        const float pos = (float)(ax == 0 ? (n >> 6) : (n & 63));
        u16* rp = base + (size_t)row * 128 + i16 * 8;
        const u32x4 v = nv; float y[8]; float ss = 0.f;
        if (r4 + nw < nrows / 4) nv = *(const u32x4*)(base + (size_t)((r4 + nw) * 4 + sub) * 128 + i16 * 8);
#pragma unroll
        for (int e = 0; e < 4; ++e) { y[2 * e] = __uint_as_float(v[e] << 16); y[2 * e + 1] = __uint_as_float(v[e] & 0xffff0000u); }
#pragma unroll
        for (int e = 0; e < 8; ++e) ss += y[e] * y[e];
        ss += __shfl_xor(ss, 1); ss += __shfl_xor(ss, 2); ss += __shfl_xor(ss, 4); ss += __shfl_xor(ss, 8);
        const float rs = rsqrtf(ss * (1.0f / 128.0f) + 1e-6f);
        float o[8];
#pragma unroll
        for (int e = 0; e < 8; ++e) { y[e] = y[e] * rs * gn[e]; }
#pragma unroll
        for (int e = 0; e < 8; ++e) { const float pr = __shfl_xor(y[e], 4); const float rev = pos * inv[e]; const float fr = rev - floorf(rev);
            const float sn = __builtin_amdgcn_sinf(fr), cs = __builtin_amdgcn_cosf(fr);
            o[e] = y[e] * cs + (sgn ? pr : -pr) * sn; }
        u32x4 w; w.x = pk2(o[0], o[1]); w.y = pk2(o[2], o[3]); w.z = pk2(o[4], o[5]); w.w = pk2(o[6], o[7]);
        *(u32x4*)rp = w;
    }
}
__device__ void ba_task(const Params& p, int g, int task, int lane) {
    const int r32 = lane & 31, hi = lane >> 5;
    const u16* u = (const u16*)(p.ws + OFF_U) + (size_t)(g * MG + task * 32 + r32) * 1024 + 8 * hi;
    const u16* wb = (const u16*)(p.ws + OFF_WBA) + (size_t)r32 * 1024 + 8 * hi;
    f32x16 acc = {};
#pragma unroll 8
    for (int ks = 0; ks < 64; ++ks) { const bf16x8 a = *(const bf16x8*)(u + ks * 16), b = *(const bf16x8*)(wb + ks * 16); acc = MFMA32(a, b, acc); }
    float* beta = (float*)(p.ws + OFF_BETA); float* gg = (float*)(p.ws + OFF_G);
    const int n = r32; const bool isb = n < 16; const int nn = n & 15;
    const float al = isb ? 0.f : -__expf(p.in[7][nn]), db = isb ? 0.f : p.in[8][nn];
#pragma unroll
    for (int r = 0; r < 16; ++r) { const int tok = g * MG + task * 32 + crow(r, hi); const float v = acc[r];
        if (isb) beta[(size_t)tok * 16 + nn] = sigm(v);
        else { const float z = v + db; const float sp = fmaxf(z, 0.f) + log1pf(__expf(-fabsf(z))); gg[(size_t)tok * 16 + nn] = al * sp; } }
}
__device__ void phase_g2(const Params& p, int g) {
    const int lane = ltid() & 63, gw = blockIdx.x * 8 + __builtin_amdgcn_readfirstlane(ltid() >> 6), nw = gridDim.x * 8;
    const int Ng = g ? 2048 : 8192;
    for (int wu = gw; wu < 2048; wu += nw) conv_unit(p, g, wu, lane);
#if defined(G2X)
    for (int wu = gw; wu < 2048; wu += nw) conv_unit(p, g, wu, lane);
#endif
    normrope_rows((u16*)(p.ws + OFF_ATK), MG * 2, 1, p.in[12], Ng, gw, nw, lane);
}

#define WBAR() do { asm volatile("s_waitcnt lgkmcnt(0)" ::: "memory"); __builtin_amdgcn_wave_barrier(); asm volatile("" ::: "memory"); } while (0)
template <int dir> __device__ __forceinline__ void prep_item(const Params& p, int g, int item, int lane0, float* sA  ) {
    int lane = lane0; asm volatile("" : "+v"(lane));
    const int h = (item >> 1) & 7, cgk = item >> 4, hq = h >> 1;
    const int r32 = lane & 31, hi = lane >> 5;
    float* sg = sA + 4096; float* sb = sg + 64;
    u16* st16 = (u16*)sA;
    const int tokg = g * MG + cgk * 64 + lane;
    const float bet = ((const float*)(p.ws + OFF_BETA))[(size_t)tokg * 16 + dir * 8 + h];
    const float gv = ((const float*)(p.ws + OFF_G))[(size_t)tokg * 16 + dir * 8 + h];
    float gc = gv;
#pragma unroll
    for (int o = 1; o < 64; o <<= 1) {
        const int src = dir == 0 ? lane - o : lane + o;
        const float t = __int_as_float(__builtin_amdgcn_ds_bpermute((src & 63) << 2, __float_as_int(gc)));
        if (dir == 0 ? (lane >= o) : (lane + o < 64)) gc += t;
    }
    const float gl = __int_as_float(__builtin_amdgcn_readlane(__float_as_int(gc), dir == 0 ? 63 : 0));
    float* aux = (float*)(p.ws + OFF_AUX);
    aux[(size_t)item * 64 + lane] = __expf(gc);
    aux[(size_t)(MiB / 4) + (size_t)item * 64 + lane] = bet;
    aux[(size_t)(2 * MiB / 4) + (size_t)item * 64 + lane] = __expf(gl - gc);
    if (lane == 0) aux[(size_t)(3 * MiB / 4) + item] = __expf(gl);
    sg[lane] = gc; sb[lane] = bet;
    const u16* kn = (const u16*)(p.ws + OFF_KN) + (size_t)(cgk * 64 + r32) * 512 + hq * 128 + 8 * hi;
    const u16* qn = (const u16*)(p.ws + OFF_QN) + (size_t)(cgk * 64 + r32) * 512 + hq * 128 + 8 * hi;
    u32x4* slot = (u32x4*)((unsigned char*)p.out + OO_SLOT + (size_t)item * 16384);
    WBAR();
    bf16x8 kf[2][8];
#pragma unroll
    for (int ks = 0; ks < 8; ++ks) { kf[0][ks] = *(const bf16x8*)(kn + ks * 16); kf[1][ks] = *(const bf16x8*)(kn + 32 * 512 + ks * 16); }
    {
        bf16x8 qf[2][8];
#pragma unroll
        for (int ks = 0; ks < 8; ++ks) { qf[0][ks] = *(const bf16x8*)(qn + ks * 16); qf[1][ks] = *(const bf16x8*)(qn + 32 * 512 + ks * 16); }
        f32x16 QK[2][2] = {};
#pragma unroll
        for (int ks = 0; ks < 8; ++ks) {
            QK[0][0] = MFMA32(qf[0][ks], kf[0][ks], QK[0][0]); if (dir != 0) QK[0][1] = MFMA32(qf[0][ks], kf[1][ks], QK[0][1]); if (dir == 0) QK[1][0] = MFMA32(qf[1][ks], kf[0][ks], QK[1][0]); QK[1][1] = MFMA32(qf[1][ks], kf[1][ks], QK[1][1]);
        }
#pragma unroll
        for (int ti = 0; ti < 2; ++ti)
#pragma unroll
            for (int tj = 0; tj < 2; ++tj) {
                const int j = 32 * tj + r32; const float gj = sg[j];
                const bool ztile = (dir == 0) ? (ti == 0 && tj == 1) : (ti == 1 && tj == 0);
#pragma unroll
                for (int r = 0; r < 16; ++r) {
                    const int i = 32 * ti + crow(r, hi); const float gi = sg[i];
                    if (ztile) { st16[i * 64 + swap23(j)] = (u16)0; continue; }
                    const float dec = __expf(fminf(gi - gj, 0.f));
                    const float mk = fminf(fmaxf((float)(dir == 0 ? i - j : j - i) + 1.0f, 0.f), 1.f);
                    st16[i * 64 + swap23(j)] = f2bf(QK[ti][tj][r] * dec * mk);
                    if ((r & 3) == 3) asm volatile("" ::: "memory");
                }
            }
    }
    WBAR();
#pragma unroll
    for (int it = 0; it < 8; ++it) slot[512 + it * 64 + lane] = ((const u32x4*)st16)[it * 64 + lane];
    WBAR();
    {
        f32x16 KK[2][2] = {};
#pragma unroll
        for (int ks = 0; ks < 8; ++ks) {
            KK[0][0] = MFMA32(kf[0][ks], kf[0][ks], KK[0][0]); if (dir != 0) KK[0][1] = MFMA32(kf[0][ks], kf[1][ks], KK[0][1]); if (dir == 0) KK[1][0] = MFMA32(kf[1][ks], kf[0][ks], KK[1][0]); KK[1][1] = MFMA32(kf[1][ks], kf[1][ks], KK[1][1]);
        }
#pragma unroll
        for (int ti = 0; ti < 2; ++ti)
#pragma unroll
            for (int tj = 0; tj < 2; ++tj) {
                const int j = 32 * tj + r32; const float gj = sg[j];
#pragma unroll
                for (int r = 0; r < 16; ++r) {
                    const int i = 32 * ti + crow(r, hi); const float gi = sg[i], bi = sb[i];
                    const int ii = dir ? 63 - i : i, jj = dir ? 63 - j : j;
                    if ((dir == 0) ? (ti == 0 && tj == 1) : (ti == 1 && tj == 0)) { sA[ii * 64 + jj] = 0.f; continue; }
                    const float dec = __expf(fminf(gi - gj, 0.f));
                    const float mk = fminf(fmaxf((float)(dir == 0 ? i - j : j - i), 0.f), 1.f);
                    sA[ii * 64 + jj] = bi * KK[ti][tj][r] * dec * mk;
                    if ((r & 3) == 3) asm volatile("" ::: "memory");
                }
            }
    }
    WBAR();
    const float fl = (float)lane;
#pragma unroll 1
    for (int gi = 0; gi < 16; ++gi) {
        const int i0 = 4 * gi;
        const float d0 = fl - (float)i0;
        float acc0 = fmaxf(1.0f - fabsf(d0), 0.f), acc1 = fmaxf(1.0f - fabsf(d0 - 1.0f), 0.f), acc2 = fmaxf(1.0f - fabsf(d0 - 2.0f), 0.f), acc3 = fmaxf(1.0f - fabsf(d0 - 3.0f), 0.f);
        const float* ar = sA + i0 * 64;
#pragma unroll 4
        for (int j4 = 0; j4 < gi; ++j4) {
            const float* xr = sA + (4 * j4) * 64 + lane;
            const float x0 = xr[0], x1 = xr[64], x2 = xr[128], x3 = xr[192];
            const f32x4 a0 = *(const f32x4*)(ar + 4 * j4), a1 = *(const f32x4*)(ar + 64 + 4 * j4), a2 = *(const f32x4*)(ar + 128 + 4 * j4), a3 = *(const f32x4*)(ar + 192 + 4 * j4);
            acc0 -= a0[0] * x0; acc0 -= a0[1] * x1; acc0 -= a0[2] * x2; acc0 -= a0[3] * x3;
            acc1 -= a1[0] * x0; acc1 -= a1[1] * x1; acc1 -= a1[2] * x2; acc1 -= a1[3] * x3;
            acc2 -= a2[0] * x0; acc2 -= a2[1] * x1; acc2 -= a2[2] * x2; acc2 -= a2[3] * x3;
            acc3 -= a3[0] * x0; acc3 -= a3[1] * x1; acc3 -= a3[2] * x2; acc3 -= a3[3] * x3;
        }
        const f32x4 t1 = *(const f32x4*)(ar + 64 + i0), t2 = *(const f32x4*)(ar + 128 + i0), t3 = *(const f32x4*)(ar + 192 + i0);
        const float y0 = acc0;
        const float y1 = acc1 - t1[0] * y0;
        const float y2 = acc2 - t2[0] * y0 - t2[1] * y1;
        const float y3 = acc3 - t3[0] * y0 - t3[1] * y1 - t3[2] * y2;
        WBAR();
        sA[(i0 + 0) * 64 + lane] = y0; sA[(i0 + 1) * 64 + lane] = y1; sA[(i0 + 2) * 64 + lane] = y2; sA[(i0 + 3) * 64 + lane] = y3;
        WBAR();
    }
    {
        u16* so = (u16*)slot;
        const int cc = swap23(dir ? 63 - lane : lane);
#pragma unroll 4
        for (int i = 0; i < 64; ++i) { const int ii = dir ? 63 - i : i; so[ii * 64 + cc] = f2bf(sA[i * 64 + lane]); }
    }
    WBAR();
}
__device__ void phase_g3(const Params& p, int g, float* lds) {
    const int lane = ltid() & 63, wv = __builtin_amdgcn_readfirstlane(ltid() >> 6), gw = blockIdx.x * 8 + wv, nw = gridDim.x * 8;
    float* sA = lds + wv * (4096 + 128);
    for (int item0 = gw; item0 < 4096; item0 += nw) { const int item = __builtin_amdgcn_readfirstlane(item0); if (item & 1) prep_item<1>(p, g, item, lane, sA); else prep_item<0>(p, g, item, lane, sA); }
}

#define LAS3 __attribute__((address_space(3)))
__device__ __forceinline__ bf16x8 lds_frag(unsigned char* lds, int byteoff) { return *(const LAS3 bf16x8*)((LAS3 unsigned char*)lds + byteoff); }
__device__ void scan_item(const Params& p, int g, int it, unsigned char* lds, bool do_store = true) {
    const int Ng = g ? 2048 : 8192, nc = Ng / 64;
    const int b = __builtin_amdgcn_readfirstlane(it >> 3), h = __builtin_amdgcn_readfirstlane(it & 7), hq = h >> 1;
    const int tid = ltid(), lane = tid & 63, wv = __builtin_amdgcn_readfirstlane(tid >> 6), dir = wv >> 2, s = wv & 3, r32 = lane & 31, hi = lane >> 5;
    const u16* kn = (const u16*)(p.ws + OFF_KN); const u16* qn = (const u16*)(p.ws + OFF_QN); const u16* kT = (const u16*)(p.ws + OFF_KT);
    const u16* vfb = (const u16*)(p.ws + OFF_VF);
    const float* aux = (const float*)(p.ws + OFF_AUX);
    u16* slots = (u16*)((unsigned char*)p.out + OO_SLOT);
    const int dbase = dir * 65536;
#define STAGE_X(st) do { _Pragma("unroll") for (int i = 0; i < 8; ++i) { const int d = i >> 2, tile = (i >> 1) & 1; \
        const int ci_ = d ? nc - 1 - (st) : (st), cg_ = b * nc + ci_; const int row = ((i & 1) * 8 + wv) * 4 + (lane >> 4), cc = (lane & 15) ^ (row & 15); \
        const u16* src = (tile ? qn : kn) + (size_t)(cg_ * 64 + row) * 512 + hq * 128 + cc * 8; \
        __builtin_amdgcn_global_load_lds((const unsigned*)src, (LAS3 unsigned*)((LAS3 unsigned char*)lds + d * 65536 + tile * 16384 + ((i & 1) * 8 + wv) * 1024), 16, 0, 0); } } while (0)
#define STAGE_Y(st) do { _Pragma("unroll") for (int i = 0; i < 8; ++i) { const int d = i >> 2, q5 = (i & 3) * 8 + wv; \
        const int ci_ = d ? nc - 1 - (st) : (st), cg_ = b * nc + ci_; const int item_ = ((cg_ * 8 + h) << 1) + d; \
        const int u = (q5 & 15) * 64 + lane, row = (q5 < 16) ? (u >> 3) : ((u & 511) >> 3), cc = (u & 7) ^ ((row >> 1) & 7); \
        const u16* src = (q5 < 16) ? kT + ((size_t)(cg_ * 4 + hq) * 128 + row) * 64 + cc * 8 : slots + (size_t)item_ * 8192 + (q5 < 24 ? 0 : 4096) + row * 64 + cc * 8; \
        __builtin_amdgcn_global_load_lds((const unsigned*)src, (LAS3 unsigned*)((LAS3 unsigned char*)lds + d * 65536 + 32768 + q5 * 1024), 16, 0, 0); } \
        if (s == 0) { const int ci_ = dir ? nc - 1 - (st) : (st), item_ = (((b * nc + ci_) * 8 + h) << 1) + dir; const int l48 = lane < 48 ? lane : 47; \
            const float* src = aux + (size_t)(l48 >> 4) * (MiB / 4) + (size_t)item_ * 64 + (l48 & 15) * 4; \
            __builtin_amdgcn_global_load_lds((const unsigned*)src, (LAS3 unsigned*)((LAS3 unsigned char*)lds + 131072 + dir * 1024), 16, 0, 0); } } while (0)
    f32x16 S[4] = {};
    STAGE_X(0); STAGE_Y(0);
    asm volatile("s_waitcnt vmcnt(0)" ::: "memory"); __syncthreads();
    for (int step = 0; step < nc; ++step) {
        const int ci = dir ? nc - 1 - step : step, cgk = b * nc + ci, item = ((cgk * 8 + h) << 1) + dir;
        u16* slot = slots + (size_t)item * 8192;
        bf16x8 Sb[4][2];
#pragma unroll
        for (int m = 0; m < 4; ++m) { Sb[m][0] = pack8(S[m], 0); Sb[m][1] = pack8(S[m], 8); }
        f32x16 P[2] = {}, Q[2] = {};
#pragma unroll
        for (int t = 0; t < 2; ++t)
#pragma unroll
            for (int m = 0; m < 4; ++m)
#pragma unroll
                for (int sp = 0; sp < 2; ++sp) {
                    const int row = 32 * t + r32, c = 4 * m + 2 * sp + hi, off = dbase + (row * 16 + (c ^ (row & 15))) * 16;
                    const bf16x8 ka = lds_frag(lds, off), qa = lds_frag(lds, off + 16384);
                    P[t] = MFMA32(ka, Sb[m][sp], P[t]); Q[t] = MFMA32(qa, Sb[m][sp], Q[t]);
                }
        const float egl = aux[(size_t)(3 * MiB / 4) + item];
        const u16* vp = vfb + ((size_t)((cgk * 8 + h) * 4 + s)) * 2048 + lane * 16;
        const u32x4 v00 = *(const u32x4*)(vp), v01 = *(const u32x4*)(vp + 8), v10 = *(const u32x4*)(vp + 1024), v11 = *(const u32x4*)(vp + 1032);
        asm volatile("s_waitcnt vmcnt(0) lgkmcnt(0)" ::: "memory"); __syncthreads();
        if (step + 1 < nc) STAGE_X(step + 1);
        const int abase = 131072 + dir * 1024 + 16 * hi;
        bf16x8 Rb[2][2];
#pragma unroll
        for (int t = 0; t < 2; ++t) {
            const u32x4 v0 = t ? v10 : v00, v1 = t ? v11 : v01;
            float vv[16];
#pragma unroll
            for (int e = 0; e < 4; ++e) { vv[2 * e] = __uint_as_float(v0[e] << 16); vv[2 * e + 1] = __uint_as_float(v0[e] & 0xffff0000u);
                vv[8 + 2 * e] = __uint_as_float(v1[e] << 16); vv[8 + 2 * e + 1] = __uint_as_float(v1[e] & 0xffff0000u); }
#pragma unroll
            for (int q = 0; q < 4; ++q) { const f32x4 eg = *(const LAS3 f32x4*)((LAS3 unsigned char*)lds + abase + (32 * t + 8 * q) * 4);
                const f32x4 bt = *(const LAS3 f32x4*)((LAS3 unsigned char*)lds + abase + 256 + (32 * t + 8 * q) * 4);
#pragma unroll
                for (int e = 0; e < 4; ++e) { const int r = 4 * q + e; P[t][r] = bt[e] * (vv[r] - eg[e] * P[t][r]); } }
            Rb[t][0] = pack8(P[t], 0); Rb[t][1] = pack8(P[t], 8);
        }
        f32x16 Vn[2] = {};
#pragma unroll
        for (int ti = 0; ti < 2; ++ti)
#pragma unroll
            for (int t = 0; t < 2; ++t)
#pragma unroll
                for (int sp = 0; sp < 2; ++sp) { const int row = 32 * ti + r32, c = 4 * t + 2 * sp + hi;
                    const bf16x8 ta = lds_frag(lds, dbase + 49152 + (row * 8 + (c ^ ((row >> 1) & 7))) * 16); Vn[ti] = MFMA32(ta, Rb[t][sp], Vn[ti]); }
        bf16x8 Vb[2][2];
#pragma unroll
        for (int t = 0; t < 2; ++t) { Vb[t][0] = pack8(Vn[t], 0); Vb[t][1] = pack8(Vn[t], 8); }
#pragma unroll
        for (int ti = 0; ti < 2; ++ti) {
#pragma unroll
            for (int q = 0; q < 4; ++q) { const f32x4 eg = *(const LAS3 f32x4*)((LAS3 unsigned char*)lds + abase + (32 * ti + 8 * q) * 4);
#pragma unroll
                for (int e = 0; e < 4; ++e) Q[ti][4 * q + e] *= eg[e]; }
#pragma unroll
            for (int t = 0; t < 2; ++t)
#pragma unroll
                for (int sp = 0; sp < 2; ++sp) { const int row = 32 * ti + r32, c = 4 * t + 2 * sp + hi;
                    const bf16x8 aa = lds_frag(lds, dbase + 57344 + (row * 8 + (c ^ ((row >> 1) & 7))) * 16); Q[ti] = MFMA32(aa, Vb[t][sp], Q[ti]); }
        }
#pragma unroll
        for (int t = 0; t < 2; ++t) {
#pragma unroll
            for (int q = 0; q < 4; ++q) { const f32x4 ek = *(const LAS3 f32x4*)((LAS3 unsigned char*)lds + abase + 512 + (32 * t + 8 * q) * 4);
#pragma unroll
                for (int e = 0; e < 4; ++e) Vn[t][4 * q + e] *= ek[e]; }
            Vb[t][0] = pack8(Vn[t], 0); Vb[t][1] = pack8(Vn[t], 8);
        }
#pragma unroll
        for (int m = 0; m < 4; ++m) {
#pragma unroll
            for (int r = 0; r < 16; ++r) S[m][r] *= egl;
#pragma unroll
            for (int t = 0; t < 2; ++t)
#pragma unroll
                for (int sp = 0; sp < 2; ++sp) { const int row = 32 * m + r32, c = 4 * t + 2 * sp + hi;
                    const bf16x8 ka = lds_frag(lds, dbase + 32768 + (row * 8 + (c ^ ((row >> 1) & 7))) * 16); S[m] = MFMA32(ka, Vb[t][sp], S[m]); }
        }
        asm volatile("s_waitcnt vmcnt(0) lgkmcnt(0)" ::: "memory"); __syncthreads();
#pragma unroll
        for (int ti = 0; ti < 2; ++ti)
#pragma unroll
            for (int r = 0; r < 16; r += 2) {
                const float a = Q[ti][r], b = Q[ti][r + 1];
                const int odd = lane & 1;
                const float rv = __int_as_float(__builtin_amdgcn_mov_dpp(__float_as_int(odd ? a : b), 0xB1, 0xF, 0xF, true));
                const unsigned w = odd ? pk2(rv, b) : pk2(a, rv);
                if (do_store) *(unsigned*)(slot + (size_t)(32 * ti + crow(r, hi) + odd) * 128 + s * 32 + (r32 & ~1)) = w;
            }
        if (step + 1 < nc) STAGE_Y(step + 1);
    }
    asm volatile("s_waitcnt vmcnt(0)" ::: "memory"); __syncthreads();
#undef STAGE_X
#undef STAGE_Y
}
__device__ void phase_g4(const Params& p, int g, unsigned char* lds) {
    const int Ng = g ? 2048 : 8192, Bg = g ? 8 : 2, nscan = Bg * 8, nqb = Ng / 256, natt = Bg * 8 * nqb, total = nscan + natt;
    unsigned* ctr = (unsigned*)(p.ws + OFF_CTR) + g * 64;
    volatile int* sitem = (volatile int*)(lds + 136 * 1024);
    att::bf16* atq = (att::bf16*)((unsigned char*)p.out + OO_ATQ);
    const att::bf16* atk = (const att::bf16*)(p.ws + OFF_ATK); const att::bf16* atv = (const att::bf16*)(p.ws + OFF_ATV);
    for (;;) {
        if (ltid() == 0) *sitem = (int)atomicAdd(ctr, 1u);
        __syncthreads();
        const int it = *sitem;
        __syncthreads();
        if (it >= total) break;
        if (it < nscan) {
#if (G4T & 1) && !(DBG & 512)
#if defined(SCANX)
            scan_item(p, g, it, lds, false);
#endif
            scan_item(p, g, it, lds);
#endif
        } else {
#if G4T & 2
            const int a = it - nscan, qb = a % nqb, h = (a / nqb) & 7, b = a / (nqb * 8);
            const size_t tok = (size_t)b * Ng + (size_t)qb * 256;
            att::bf16* Qb = atq + tok * 1024 + h * 128;
            const size_t kvo = (size_t)b * Ng * 256 + (h >> 2) * 128;
#if DBG & 256
            { u16* q16 = (u16*)Qb; for (int e = ltid(); e < 256 * 16; e += 512) { const int r = e >> 4, c8 = (e & 15) * 8; *(u32x4*)(q16 + (size_t)r * 1024 + c8) = (u32x4){0u, 0u, 0u, 0u}; } }
#elif !(DBG & 128)
#if defined(ATTX)
            att::attn_dense_body<att::bf16>(Qb, atk + kvo, atv + kvo, Qb, Ng, (char*)lds, false);
            __syncthreads();
#endif
            att::attn_dense_body<att::bf16>(Qb, atk + kvo, atv + kvo, Qb, Ng, (char*)lds, true, p.in[11], qb * 256);
#endif
            __syncthreads();
#endif
        }
    }
}

__device__ void phase_g5(const Params& p, int g) {
    const int lane = ltid() & 63, gw = blockIdx.x * 8 + __builtin_amdgcn_readfirstlane(ltid() >> 6), nw = gridDim.x * 8, i16 = lane & 15, sub = lane >> 4;
    const u16* slots = (const u16*)((unsigned char*)p.out + OO_SLOT); u16* sz = (u16*)((unsigned char*)p.out + OO_SZ);
    float gn[8];
    { const f32x4 a = *(const f32x4*)(p.in[9] + i16 * 8), b = *(const f32x4*)(p.in[9] + i16 * 8 + 4); gn[0] = a[0]; gn[1] = a[1]; gn[2] = a[2]; gn[3] = a[3]; gn[4] = b[0]; gn[5] = b[1]; gn[6] = b[2]; gn[7] = b[3]; }
    u32x4 na = {0u, 0u, 0u, 0u}, nb = na, nz = na;
#define G5_ADDR(R4) const int row_ = (R4) * 4 + sub, t_ = row_ >> 3, h_ = row_ & 7, cgk_ = t_ >> 6, c_ = t_ & 63; \
        const u16* of_ = slots + ((size_t)((cgk_ * 8 + h_) << 1)) * 8192 + c_ * 128 + i16 * 8; u16* zp_ = sz + (size_t)t_ * 1024 + h_ * 128 + i16 * 8;
    if (gw < MG * 8 / 4) { G5_ADDR(gw) na = *(const u32x4*)of_; nb = *(const u32x4*)(of_ + 8192); nz = *(const u32x4*)zp_; }
    for (int r4 = gw; r4 < MG * 8 / 4; r4 += nw) {
        const int row = r4 * 4 + sub, t = row >> 3, h = row & 7;
        u16* zp = sz + (size_t)t * 1024 + h * 128 + i16 * 8;
        const u32x4 a = na, b = nb, z = nz;
        if (r4 + nw < MG * 8 / 4) { G5_ADDR(r4 + nw) na = *(const u32x4*)of_; nb = *(const u32x4*)(of_ + 8192); nz = *(const u32x4*)zp_; }
        float y[8]; float ss = 0.f;
#pragma unroll
        for (int e = 0; e < 4; ++e) { y[2 * e] = __uint_as_float(a[e] << 16) + __uint_as_float(b[e] << 16); y[2 * e + 1] = __uint_as_float(a[e] & 0xffff0000u) + __uint_as_float(b[e] & 0xffff0000u); }
#pragma unroll
        for (int e = 0; e < 8; ++e) ss += y[e] * y[e];
        ss += __shfl_xor(ss, 1); ss += __shfl_xor(ss, 2); ss += __shfl_xor(ss, 4); ss += __shfl_xor(ss, 8);
        const float rs = rsqrtf(ss * (1.0f / 128.0f) + 1e-6f);
        float o[8];
#pragma unroll
        for (int e = 0; e < 4; ++e) { o[2 * e] = y[2 * e] * rs * gn[2 * e] * __uint_as_float(z[e] << 16); o[2 * e + 1] = y[2 * e + 1] * rs * gn[2 * e + 1] * __uint_as_float(z[e] & 0xffff0000u); }
        u32x4 w; w.x = pk2(o[0], o[1]); w.y = pk2(o[2], o[3]); w.z = pk2(o[4], o[5]); w.w = pk2(o[6], o[7]);
        *(u32x4*)zp = w;
    }
}

#define XB_TMO      128
#define XB_XCNT(j)  (256  + 64 * (j))
#define XB_XSUB(j)  (1280 + 64 * (j))
#define XB_XGEN(j)  (2304 + 64 * (j))
#define XB_TOP      3328
#define XB_TOPGEN   3392
#define XCD_BAR_WORDS 3456
#define XB_SPIN_CAP (1u << 18)
#define LAS __attribute__((address_space(3)))

__device__ __forceinline__ unsigned xb_ld(unsigned* p)              { return __hip_atomic_load(p, __ATOMIC_RELAXED, __HIP_MEMORY_SCOPE_AGENT); }
__device__ __forceinline__ unsigned xb_add(unsigned* p, unsigned v) { return __hip_atomic_fetch_add(p, v, __ATOMIC_RELAXED, __HIP_MEMORY_SCOPE_AGENT); }
__device__ __forceinline__ unsigned xb_xcc_id() { return (unsigned)__builtin_amdgcn_s_getreg((3 << 11) | 20) & 0xFu; }
#define XB_SPIN(cond, bar) do { unsigned _sp = 0; while (cond) { __builtin_amdgcn_s_sleep(1); \
    if ((++_sp & 255u) == 0u) { if (xb_ld(&(bar)[XB_TMO])) break; if (_sp > XB_SPIN_CAP) { atomicAdd(&(bar)[XB_TMO], 1u); break; } } } } while (0)

struct XcdBarrier {
    unsigned* bar; unsigned x;
    volatile LAS unsigned* st;
};

__device__ __forceinline__ XcdBarrier xcd_barrier_post(unsigned* bar, volatile LAS unsigned* st) {
    XcdBarrier b; b.bar = bar; b.x = xb_xcc_id(); b.st = st;
    if (ltid() == 0) (void)xb_add(&bar[XB_XCNT(b.x)], 1u);
    return b;
}
__device__ __forceinline__ void xcd_barrier_complete(unsigned* bar, unsigned x, unsigned& nloc, unsigned& nx) {
    const unsigned G = gridDim.x * gridDim.y * gridDim.z;
    unsigned sum, cnt, mine, sp = 0u;
    for (;;) {
        sum = 0u; cnt = 0u; mine = 0u;
#pragma unroll
        for (unsigned j = 0; j < 16; ++j) { const unsigned c = xb_ld(&bar[XB_XCNT(j)]); sum += c; cnt += (c > 0u) ? 1u : 0u; mine = (j == x) ? c : mine; }
        if (sum == G) break;
        __builtin_amdgcn_s_sleep(1);
        if ((++sp & 255u) == 0u) { if (xb_ld(&bar[XB_TMO])) break; if (sp > XB_SPIN_CAP) { atomicAdd(&bar[XB_TMO], 1u); break; } }
    }
    nloc = mine > 0u ? mine : 1u; nx = cnt > 0u ? cnt : 1u;
}

__device__ __forceinline__ void xcd_barrier(const XcdBarrier& b) {
    asm volatile("s_waitcnt vmcnt(0)" ::: "memory");
    __syncthreads();
    if (ltid() == 0) {
        unsigned* bar = b.bar;
        __builtin_amdgcn_s_waitcnt(0);
        unsigned nloc = b.st[0], nx = b.st[1];
        if (nloc == 0u) { xcd_barrier_complete(bar, b.x, nloc, nx); b.st[0] = nloc; b.st[1] = nx; }
        const unsigned old = xb_add(&bar[XB_XSUB(b.x)], 1u);
        const unsigned gen = old / nloc;
        if (old + 1u == (gen + 1u) * nloc) {
            __builtin_amdgcn_fence(__ATOMIC_RELEASE, "agent");
            asm volatile("s_waitcnt vmcnt(0)" ::: "memory");
            const unsigned og = xb_add(&bar[XB_TOP], 1u);
            const unsigned tg = og / nx;
            if (og + 1u == (tg + 1u) * nx) xb_add(&bar[XB_TOPGEN], 1u);
            else XB_SPIN(xb_ld(&bar[XB_TOPGEN]) == tg, bar);
            __builtin_amdgcn_fence(__ATOMIC_ACQUIRE, "agent");
            xb_add(&bar[XB_XGEN(b.x)], 1u);
            asm volatile("s_waitcnt vmcnt(0)" ::: "memory");
        } else {
            XB_SPIN(xb_ld(&bar[XB_XGEN(b.x)]) == gen, bar);
            __builtin_amdgcn_fence(__ATOMIC_ACQUIRE, "agent");
            asm volatile("s_waitcnt vmcnt(0)" ::: "memory");
        }
    }
    __syncthreads();
}


__global__ void __launch_bounds__(512) mega(Params p) {
    extern __shared__ __attribute__((aligned(16))) unsigned char lds[];
    cg::grid_group grid = cg::this_grid();
    unsigned char* ws = p.ws;
#if defined(RLO)
    int rep_done = 0;
#define RHI2 RHI
#endif
#if defined(RMASK)
    unsigned rep_m = 0;
#endif
#if defined(XSYNC)
    for (int xs = 0; xs < XSYNC; ++xs) grid.sync();
#endif
    volatile LAS unsigned* xst = (volatile LAS unsigned*)((LAS unsigned char*)lds + 136 * 1024 + 16);
    if (ltid() < 2) xst[ltid()] = 0u;
    __syncthreads();
    XcdBarrier xb = xcd_barrier_post((unsigned*)(p.ws + OFF_CTR + 4096), xst);
    for (int ph = p.ph_lo; ph < p.ph_hi; ++ph) {
        if (ph > p.ph_lo) { if (p.ph_hi > 1000) grid.sync(); else xcd_barrier(xb); }
#if DBG & 4
        if (ph >= 19) continue;
#endif
#if DBG & 8
        if (ph >= 14 && ph <= 18) continue;
#endif
        if (ph == 0) {
#if PHM & 1
            phase_tconv(p, (float*)lds);
            phase_rmsnorm(p.in[0], p.in[1], p.in[4], (u16*)(ws + OFF_U));
#endif
        } else if (ph <= 12) {
            const int g = (ph - 1) / 6, sp = (ph - 1) % 6;
            if (sp == 1) {
#if PHM & 4
                phase_g2(p, g);
#endif
            } else if (sp == 2) {
#if PHM & 8
                phase_g3(p, g, (float*)lds);
#endif
            } else if (sp == 3) {
#if PHM & 16
                phase_g4(p, g, lds);
#endif
            } else if (sp == 4) {
#if PHM & 32
                phase_g5(p, g);
#endif
            }
        } else if (ph == 14) {
            phase_rmsnorm(p.out, p.out + (size_t)MG * 1024, p.in[15], (u16*)(ws + OFF_U));
        } else if (ph == 19) {
            phase_rmsnorm(p.out, p.out + (size_t)MG * 1024, p.in[18], (u16*)(ws + OFF_U));
            phase_pe_cvt(p.in[2], p.in[3], (u16*)(ws + OFF_PE));
        }
#if PHM & 2
#pragma unroll 1
        for (int k = 0; k < 4; ++k) {
            GDesc d;
            if (!get_desc(p, ph, k, d)) break;
            pg8::Gemm gm; gm.A = d.A; gm.Bt = d.Bt; gm.M = d.M; gm.N = d.N; gm.K = d.K;
            pg8::StaticOrder S; S.init(d.M, d.N, (int)gridDim.x, (int)blockIdx.x);
            pg8::gemm_phase<GEpi, pg8::StaticOrder, false>((PG8_LAS unsigned char*)lds, gm, S, d.e, nullptr);
            __syncthreads();
        }
        if (ph >= 1 && ph <= 12 && (ph - 1) % 6 == 0) {
            const int half = (int)gridDim.x / 2, gwb = ((int)blockIdx.x - half) * 8 + __builtin_amdgcn_readfirstlane(ltid() >> 6), nwb = ((int)gridDim.x - half) * 8;
            if ((int)blockIdx.x >= half) for (int task = gwb; task < MG / 32; task += nwb) ba_task(p, (ph - 1) / 6, task, ltid() & 63);
        }
#endif
#if defined(RLO)
        if (ph == RHI && !rep_done) { rep_done = 1; ph = RLO - 1; }
        else if (ph == RHI && rep_done && ph != RHI2) rep_done = 0 * 0 + 1;
#endif
#if defined(RMASK)
        if (((RMASK >> ph) & 1) && !(rep_m & (1u << ph))) { rep_m |= 1u << ph; --ph; }
#endif
    }
}

__global__ void dbg_copy(const float* a, const float* b, float* o) { for (size_t i = (size_t)blockIdx.x * 256 + threadIdx.x; i < (size_t)MALL * 1024; i += (size_t)gridDim.x * 256) o[i] = i < (size_t)MG * 1024 ? a[i] : b[i - (size_t)MG * 1024]; }
#ifndef PH_END
#define PH_END NPHASE
#endif
#ifndef ONE_LAUNCH
#define ONE_LAUNCH 1
#endif
extern "C" void kernel_launch(void* const* d_in, const int* in_sizes, int n_in, void* d_out, int out_size, void* d_ws, size_t ws_size, hipStream_t stream) {
    static int grid = 0;
    if (grid == 0) {
        if (n_in != 21 || ws_size < 256 * MiB) { fprintf(stderr, "kernel_launch: unexpected n_in %d / ws %zu\n", n_in, ws_size); grid = -1; return; }
        if (hipFuncSetAttribute((const void*)mega, hipFuncAttributeMaxDynamicSharedMemorySize, LDS_BYTES) != hipSuccess) { fprintf(stderr, "kernel_launch: hipFuncSetAttribute failed\n"); grid = -1; return; }
        int dev = 0, cus = 0, per_cu = 0;
        hipGetDevice(&dev); hipDeviceGetAttribute(&cus, hipDeviceAttributeMultiprocessorCount, dev);
        hipOccupancyMaxActiveBlocksPerMultiprocessor(&per_cu, (const void*)mega, 512, LDS_BYTES);
        if (per_cu < 1) { fprintf(stderr, "kernel_launch: occupancy query says %d blocks/CU\n", per_cu); per_cu = 1; }
        (void)hipGetLastError();
        grid = cus;
    }
    if (grid < 0) return;
    hipMemsetAsync((unsigned char*)d_ws + OFF_CTR, 0, 32768, stream);
#if DBG & 32
    hipLaunchKernelGGL(dbg_copy, dim3(2048), dim3(256), 0, stream, (const float*)d_in[0], (const float*)d_in[1], (float*)d_out); return;
#endif
    Params p{};
    for (int i = 0; i < 21; ++i) p.in[i] = (const float*)d_in[i];
    p.out = (float*)d_out; p.ws = (unsigned char*)d_ws;
#if ONE_LAUNCH
    p.ph_lo = 0; p.ph_hi = NPHASE;
    void* args[] = {&p};
    hipError_t e = hipLaunchCooperativeKernel((const void*)mega, dim3(grid), dim3(512), args, LDS_BYTES, stream);
    if (e != hipSuccess) fprintf(stderr, "cooperative launch failed: %s (grid %d)\n", hipGetErrorString(e), grid);
#else
    for (int ph = 0; ph < PH_END; ++ph) {
#if DBG & 64
        if (ph == 1) hipMemsetAsync((unsigned char*)d_ws + OFF_MERGED, 0, 64 * MiB, stream);
        if (ph >= 1 && ph <= 12) continue;
#endif
        p.ph_lo = ph; p.ph_hi = ph + 1;
        hipLaunchKernelGGL(mega, dim3(grid), dim3(512), LDS_BYTES, stream, p);
    }
    hipError_t e = hipPeekAtLastError();
    if (e != hipSuccess) fprintf(stderr, "launch failed: %s\n", hipGetErrorString(e));
#endif
}
```

```cpp
#include <hip/hip_runtime.h>
#include <hip/hip_bf16.h>
#include <hip/hip_cooperative_groups.h>
#include <cstdio>
#include <cstdint>
namespace cg = cooperative_groups;
typedef unsigned short u16;
__device__ __forceinline__ int ltid() { int t = (int)threadIdx.x; asm volatile("" : "+v"(t)); return t; }
#ifndef DBG
#define DBG 0
#endif
#ifndef G4T
#define G4T 3
#endif
#ifndef G6T
#define G6T 15
#endif
#ifndef PHM
#define PHM 255
#endif
namespace pg8 {
#define PG8_LAS __attribute__((address_space(3)))
typedef unsigned short bf16_t;
typedef short bf16x8 __attribute__((ext_vector_type(8)));
typedef float f32x4 __attribute__((ext_vector_type(4)));
typedef unsigned u32x4 __attribute__((ext_vector_type(4)));
constexpr int BM = 256, BK = 64, HALF = 128, HTB = HALF * BK * 2  , STAGE_BYTES = 8 * HTB, NXCD = 8, WGM = 8;

__host__ __device__ __forceinline__ int lds_byte(int r, int c) { const int st = (r >> 4) * 2 + (c >> 5), rr = r & 15, cc = c & 31, ob = rr * 64 + cc * 2; return st * 1024 + (ob ^ (((ob >> 9) & 1) << 5)); }
__host__ __device__ __forceinline__ void stage_rc(int b, int& R, int& C) { const int st = b / 1024, sb = b % 1024, swz = sb ^ (((sb >> 9) & 1) << 5); R = (st >> 1) * 16 + swz / 64; C = (st & 1) * 32 + (swz % 64) / 2; }
__host__ __device__ __forceinline__ int perm32(int rho) { const int n = rho >> 4, i = rho & 15; return 8 * (i >> 2) + 4 * n + (i & 3); }

struct Unit { int pm, pn; };
struct Gemm { const bf16_t* A; const bf16_t* Bt; int M, N, K; };

struct StaticOrder {
    int nM, nN, nwg, G, c;
    __host__ __device__ void init(int M, int N, int G_, int c_) { nM = M / BM; nN = N / BM; nwg = nM * nN; G = G_; c = c_; }
    __host__ __device__ bool next(int i, Unit& u) const {
        const long L = (long)i * G + c; if (L >= nwg) return false;
        int wgid = (int)L; { const int q = nwg / NXCD, r = nwg % NXCD, xcd = wgid % NXCD, off = wgid / NXCD; wgid = (xcd < r ? xcd * (q + 1) : r * (q + 1) + (xcd - r) * q) + off; }
        const int nig = WGM * nN, gid = wgid / nig, fm = gid * WGM, gsz = (nM - fm) < WGM ? (nM - fm) : WGM;
        u.pm = fm + ((wgid % nig) % gsz); u.pn = (wgid % nig) / gsz; return true;
    }
    __device__ __forceinline__ void a_ready(const Unit&) const {}
    __device__ __forceinline__ void done(const Unit&) const {}
};
__device__ __forceinline__ unsigned cvt_pk_bf16(float lo, float hi) { unsigned r; asm volatile("v_cvt_pk_bf16_f32 %0, %1, %2" : "=v"(r) : "v"(lo), "v"(hi)); return r; }
typedef float f32x2 __attribute__((ext_vector_type(2)));
template <class Epi, class Sched, bool STAMP = false>
__device__ __forceinline__ void gemm_phase(PG8_LAS unsigned char* lds, const Gemm g, const Sched& S, const Epi& E, unsigned long long* stamps) {
    const int tid = ltid(), wid = __builtin_amdgcn_readfirstlane(tid >> 6), lane = tid & 63, wr = wid >> 2, wc = wid & 3, fr = lane & 15, fq = lane >> 4;
    const int K = g.K, nt = K / BK;
    int ts_lo = 0, ts_hi = 0, nts = 0; const unsigned long long rt_entry = STAMP ? (unsigned long long)wall_clock64() : 0ull;
#define PG8_STAMP() do { if (STAMP && wid == 0 && nts < 64) { const unsigned long long _c = (unsigned long long)clock64(); \
        ts_lo = (lane == nts) ? (int)(unsigned)_c : ts_lo; ts_hi = (lane == nts) ? (int)(unsigned)(_c >> 32) : ts_hi; ++nts; } } while (0)
    PG8_STAMP();
    unsigned voffA[2], voffB[2];
#pragma unroll
    for (int i = 0; i < 2; ++i) { int R, C; stage_rc(tid * 16 + i * 8192, R, C); const int Rb = E.perm ? ((R & ~31) + perm32(R & 31)) : R;
        voffA[i] = (unsigned)(R * K + C) * 2u; voffB[i] = (unsigned)(Rb * K + C) * 2u; }
    const size_t kstep = (size_t)(BK * 2);
    const size_t hstep = (size_t)HALF * K * 2;
    const size_t tstep = 2 * hstep;
    const unsigned ldsw = (unsigned)wid * 1024u;
    const int aoff = lds_byte(wr * 64 + fr, fq * 8), boff = lds_byte(wc * 32 + fr, fq * 8);
#define PG8_SA(b, h) (((b) * 2 + (h)) * HTB)
#define PG8_SB(b, h) ((4 + (b) * 2 + (h)) * HTB)
#define PG8_STAGE(bufoff, gbase, voff) do { _Pragma("unroll") for (int _i = 0; _i < 2; ++_i) \
        __builtin_amdgcn_global_load_lds((const unsigned*)((const char*)(gbase) + (voff)[_i]), (PG8_LAS unsigned*)(lds + (bufoff) + ldsw + _i * 8192), 16, 0, 0); } while (0)
#define PG8_LDA(dst, b, h) do { _Pragma("unroll") for (int m = 0; m < 4; ++m) _Pragma("unroll") for (int k = 0; k < 2; ++k) dst[m][k] = *(const PG8_LAS bf16x8*)(lds + PG8_SA(b, h) + aoff + m * 2048 + k * 1024); } while (0)
#define PG8_LDB(dst, b, h) do { _Pragma("unroll") for (int n = 0; n < 2; ++n) _Pragma("unroll") for (int k = 0; k < 2; ++k) dst[n][k] = *(const PG8_LAS bf16x8*)(lds + PG8_SB(b, h) + boff + n * 2048 + k * 1024); } while (0)
#define PG8_MMA(ai, bj, At, Bt) do { __builtin_amdgcn_s_setprio(1); _Pragma("unroll") for (int m = 0; m < 4; ++m) _Pragma("unroll") for (int n = 0; n < 2; ++n) _Pragma("unroll") for (int k = 0; k < 2; ++k) \
        acc[ai][bj][m][n] = __builtin_amdgcn_mfma_f32_16x16x32_bf16(Bt[n][k], At[m][k], acc[ai][bj][m][n], 0, 0, 0); __builtin_amdgcn_s_setprio(0); } while (0)
#define PG8_WAIT_V(n) asm volatile("s_waitcnt vmcnt(" #n ")" ::: "memory")
#define PG8_WAIT_L(n) asm volatile("s_waitcnt lgkmcnt(" #n ")" ::: "memory")
#define PG8_BAR __builtin_amdgcn_s_barrier()
#define PG8_SCHED __builtin_amdgcn_sched_barrier(0)
    Unit cur, nxt; int ui = 0;
    if (!S.next(0, cur)) return;
    f32x4 acc[2][2][4][2];
#pragma unroll
    for (int a = 0; a < 2; ++a)
#pragma unroll
        for (int b = 0; b < 2; ++b)
#pragma unroll
            for (int m = 0; m < 4; ++m)
#pragma unroll
                for (int n = 0; n < 2; ++n) acc[a][b][m][n] = (f32x4){0.f, 0.f, 0.f, 0.f};
    bf16x8 At[4][2], B0[2][2], B1[2][2];
    const char* cA = (const char*)g.A + (size_t)cur.pm * tstep; const char* cB = (const char*)g.Bt + (size_t)cur.pn * tstep;
    S.a_ready(cur);
    PG8_STAGE(PG8_SB(0, 0), cB, voffB); PG8_STAGE(PG8_SA(0, 0), cA, voffA); PG8_STAGE(PG8_SB(0, 1), cB + hstep, voffB); PG8_STAGE(PG8_SA(0, 1), cA + hstep, voffA);
    if (wr == 1) PG8_BAR;
    PG8_WAIT_V(4); PG8_BAR;
    PG8_STAGE(PG8_SB(1, 0), cB + kstep, voffB); PG8_STAGE(PG8_SA(1, 0), cA + kstep, voffA); PG8_STAGE(PG8_SB(1, 1), cB + hstep + kstep, voffB);
    PG8_WAIT_V(6); PG8_BAR;
    PG8_STAMP();
    for (;;) {
        const bool has_next = S.next(ui + 1, nxt);
        const char* nA = has_next ? (const char*)g.A + (size_t)nxt.pm * tstep : cA; const char* nB = has_next ? (const char*)g.Bt + (size_t)nxt.pn * tstep : cB;
        for (int t = 0; t < nt; t += 2) {
            const bool last = (t == nt - 2);
            const char* a1 = cA + (size_t)(t + 1) * kstep;
            const char* a2 = last ? nA : cA + (size_t)(t + 2) * kstep; const char* b2 = last ? nB : cB + (size_t)(t + 2) * kstep;
            const char* a3 = a2 + kstep; const char* b3 = b2 + kstep;
            if (last && has_next) S.a_ready(nxt);
            PG8_LDB(B0, 0, 0); PG8_SCHED; PG8_LDA(At, 0, 0); PG8_STAGE(PG8_SA(1, 1), a1 + hstep, voffA);
            PG8_WAIT_L(8); PG8_BAR; PG8_WAIT_L(0); PG8_MMA(0, 0, At, B0); PG8_BAR; PG8_SCHED;
            PG8_LDB(B1, 0, 1); PG8_STAGE(PG8_SB(0, 0), b2, voffB);
            PG8_BAR; PG8_WAIT_L(0); PG8_MMA(0, 1, At, B1); PG8_BAR;
            PG8_LDA(At, 0, 1); PG8_STAGE(PG8_SA(0, 0), a2, voffA);
            PG8_BAR; PG8_WAIT_L(0); PG8_MMA(1, 0, At, B0); PG8_BAR; PG8_SCHED;
            PG8_STAGE(PG8_SB(0, 1), b2 + hstep, voffB);
            PG8_WAIT_V(6); PG8_BAR; PG8_MMA(1, 1, At, B1); PG8_BAR;
            PG8_LDB(B0, 1, 0); PG8_SCHED; PG8_LDA(At, 1, 0); PG8_STAGE(PG8_SA(0, 1), a2 + hstep, voffA);
            PG8_WAIT_L(8); PG8_BAR; PG8_WAIT_L(0); PG8_MMA(0, 0, At, B0); PG8_BAR; PG8_SCHED;
            PG8_LDB(B1, 1, 1); PG8_STAGE(PG8_SB(1, 0), b3, voffB);
            PG8_BAR; PG8_WAIT_L(0); PG8_MMA(0, 1, At, B1); PG8_BAR;
            PG8_LDA(At, 1, 1); PG8_STAGE(PG8_SA(1, 0), a3, voffA);
            PG8_BAR; PG8_WAIT_L(0); PG8_MMA(1, 0, At, B0); PG8_BAR; PG8_SCHED;
            PG8_STAGE(PG8_SB(1, 1), b3 + hstep, voffB);
            PG8_WAIT_V(6); PG8_BAR; PG8_MMA(1, 1, At, B1); PG8_BAR;
        }
        PG8_STAMP();
        if constexpr (!Epi::AFTER_DRAIN) { E(acc, cur, wr, wc, fr, fq); S.done(cur); }
        PG8_STAMP();
        if (!has_next) break;
#pragma unroll
        for (int a = 0; a < 2; ++a)
#pragma unroll
            for (int b = 0; b < 2; ++b)
#pragma unroll
                for (int m = 0; m < 4; ++m)
#pragma unroll
                    for (int n = 0; n < 2; ++n) acc[a][b][m][n] = (f32x4){0.f, 0.f, 0.f, 0.f};
        cur = nxt; cA = nA; cB = nB; ++ui;
    }
    PG8_WAIT_V(0);
    if (wr == 0) PG8_BAR;
    PG8_BAR;
    if constexpr (Epi::AFTER_DRAIN) { E.fused(acc, cur, wr, wc, fr, fq, lds, wid, lane); S.done(cur); }
    PG8_STAMP();
    if (STAMP && wid == 0) { stamps[lane] = lane < nts ? (((unsigned long long)(unsigned)ts_hi << 32) | (unsigned)ts_lo) : 0ull;
        if (lane == 62) stamps[62] = rt_entry; if (lane == 63) stamps[63] = (unsigned long long)wall_clock64(); }
#undef PG8_STAMP
#undef PG8_SA
#undef PG8_SB
#undef PG8_STAGE
#undef PG8_LDA
#undef PG8_LDB
#undef PG8_MMA
#undef PG8_WAIT_V
#undef PG8_WAIT_L
#undef PG8_BAR
#undef PG8_SCHED
}
}
namespace att {
using bf16 = __hip_bfloat16;
constexpr int   D = 128, NW = 8, QBLK = 32, KVBLK = 64;
constexpr float SCALE = 0.088388347648318440f;
constexpr float THR = 8.f;
constexpr int SDEPTH = 2;
constexpr int LDQ = 1024, LDK = 256, LDO = 1024;
constexpr size_t SHM_V = KVBLK * D * 2, SHM_K = KVBLK * D * 2, SHM_ATTN = 2 * SHM_V + 2 * SHM_K + NW * 64 * 4;
using bf16x8 = __attribute__((ext_vector_type(8))) short;
using s16x4  = __attribute__((ext_vector_type(4))) short;
using f32x16 = __attribute__((ext_vector_type(16))) float;
using f32x8  = __attribute__((ext_vector_type(8))) float;
using u32x4  = __attribute__((ext_vector_type(4))) unsigned;
#define KSWZ(row, colB) ((row) * 256 + ((colB) ^ (((row) & 7) << 4)))
#define SBAR() __builtin_amdgcn_sched_barrier(0)
__device__ __forceinline__ int crow(int r, int hi) { return (r & 3) + 8 * (r >> 2) + 4 * hi; }
__device__ __forceinline__ unsigned cvtpk(float lo, float hi) {
  unsigned r; asm volatile("v_cvt_pk_bf16_f32 %0, %1, %2" : "=v"(r) : "v"(lo), "v"(hi)); return r;
}
template <typename TIn> struct Stage;
template <> struct Stage<bf16>  { using T = bf16x8;
  __device__ static __forceinline__ T ld8(const bf16* p) { return *reinterpret_cast<const bf16x8*>(p); }
  __device__ static __forceinline__ bf16x8 tobf(T x) { return x; } };
template <> struct Stage<float> { using T = f32x8;
  __device__ static __forceinline__ T ld8(const float* p) { return *reinterpret_cast<const f32x8*>(p); }
  __device__ static __forceinline__ bf16x8 tobf(T x) {
    u32x4 w = {cvtpk(x[0], x[1]), cvtpk(x[2], x[3]), cvtpk(x[4], x[5]), cvtpk(x[6], x[7])}; return *reinterpret_cast<bf16x8*>(&w); } };

__device__ __forceinline__ void partialSM(f32x16& p0, f32x16& p1, float& m_reg, float& mn, float& alpha) {
  constexpr float C = SCALE * 1.4426950408889634f;
  float pmax = p0[0]; for (int r = 1; r < 16; ++r) pmax = fmaxf(pmax, p0[r]); for (int r = 0; r < 16; ++r) pmax = fmaxf(pmax, p1[r]);
  { auto rr = __builtin_amdgcn_permlane32_swap(__float_as_uint(pmax), __float_as_uint(pmax), false, false);
    pmax = fmaxf(__uint_as_float(rr[0]), __uint_as_float(rr[1])); }
  if (__builtin_expect(__all(pmax - m_reg <= THR / SCALE), 1)) { mn = m_reg; alpha = 1.f; }
  else { mn = fmaxf(m_reg, pmax); alpha = __builtin_amdgcn_exp2f((m_reg - mn) * C); m_reg = mn; }
  float mnC = -mn * C;
  for (int r = 0; r < 16; ++r) p0[r] = fmaf(p0[r], C, mnC); for (int r = 0; r < 16; ++r) p1[r] = fmaf(p1[r], C, mnC);
  for (int r = 0; r < 16; ++r) p0[r] = __builtin_amdgcn_exp2f(p0[r]);
}
__device__ __forceinline__ void finishSM(f32x16& p0, f32x16& p1, float alpha, float& l_reg, bf16x8& pa0, bf16x8& pa1, bf16x8& pa2, bf16x8& pa3) {
  for (int r = 0; r < 16; ++r) p1[r] = __builtin_amdgcn_exp2f(p1[r]);
  float ps = 0; for (int r = 0; r < 16; ++r) ps += p0[r]; for (int r = 0; r < 16; ++r) ps += p1[r];
  { auto rr = __builtin_amdgcn_permlane32_swap(__float_as_uint(ps), __float_as_uint(ps), false, false);
    ps = __uint_as_float(rr[0]) + __uint_as_float(rr[1]); }
  l_reg = l_reg * alpha + ps;
#define PK4(P, BASE, OUT) do { unsigned a0 = cvtpk(P[BASE + 0], P[BASE + 1]), a1 = cvtpk(P[BASE + 2], P[BASE + 3]);   \
    unsigned b0 = cvtpk(P[BASE + 4], P[BASE + 5]), b1 = cvtpk(P[BASE + 6], P[BASE + 7]);                              \
    auto r0 = __builtin_amdgcn_permlane32_swap(a0, b0, false, false); auto r1 = __builtin_amdgcn_permlane32_swap(a1, b1, false, false); \
    u32x4 w = {r0[0], r1[0], r0[1], r1[1]}; OUT = *reinterpret_cast<bf16x8*>(&w); } while (0)
  PK4(p0, 0, pa0); PK4(p0, 8, pa1); PK4(p1, 0, pa2); PK4(p1, 8, pa3);
#undef PK4
}
__device__ __forceinline__ void qkt(f32x16& p0, f32x16& p1, const bf16* Ks, const bf16x8* qr, int r32, int hi) {
  p0 = f32x16{}; p1 = f32x16{};
  for (int d0 = 0; d0 < 8; ++d0) { int cb = (d0 * 16 + hi * 8) * 2;
    bf16x8 b0 = *reinterpret_cast<const bf16x8*>((const char*)Ks + KSWZ(r32, cb));
    bf16x8 b1 = *reinterpret_cast<const bf16x8*>((const char*)Ks + KSWZ(32 + r32, cb));
    p0 = __builtin_amdgcn_mfma_f32_32x32x16_bf16(b0, qr[d0], p0, 0, 0, 0);
    p1 = __builtin_amdgcn_mfma_f32_32x32x16_bf16(b1, qr[d0], p1, 0, 0, 0); }
}
__device__ __forceinline__ int v_st(int k, int c) { const int kk = (k & ~0xC) | ((k & 4) << 1) | ((k & 8) >> 1); return ((kk >> 3) * 4 + (c >> 5)) * 512 + ((kk & 7) * 32 + (c & 31)) * 2; }
__device__ __forceinline__ int v_rd_base(int lane) { return ((lane & 3) << 3) | (((lane >> 2) & 3) << 6) | (((lane >> 4) & 1) << 5) | (((lane >> 5) & 1) << 8); }
constexpr int v_rd_off(int d0, int ks, int half) { return d0 * 512 + ks * 4096 + half * 2048; }
template <int OFF> __device__ __forceinline__ s16x4 tr_read(int vb) {
  s16x4 r; asm volatile("ds_read_b64_tr_b16 %0, %1 offset:%2" : "=&v"(r) : "v"(vb), "i"(OFF) : "memory"); return r;
}
template <int D0> __device__ __forceinline__ void pv_one(f32x16& od, int vb, bf16x8 pa0, bf16x8 pa1, bf16x8 pa2, bf16x8 pa3) {
  const s16x4 l0 = tr_read<v_rd_off(D0, 0, 0)>(vb), h0 = tr_read<v_rd_off(D0, 0, 1)>(vb), l1 = tr_read<v_rd_off(D0, 1, 0)>(vb), h1 = tr_read<v_rd_off(D0, 1, 1)>(vb);
  const s16x4 l2 = tr_read<v_rd_off(D0, 2, 0)>(vb), h2 = tr_read<v_rd_off(D0, 2, 1)>(vb), l3 = tr_read<v_rd_off(D0, 3, 0)>(vb), h3 = tr_read<v_rd_off(D0, 3, 1)>(vb);
  asm volatile("s_waitcnt lgkmcnt(0)" ::: "memory"); SBAR();
#define PK(L, H) (bf16x8){L[0], L[1], L[2], L[3], H[0], H[1], H[2], H[3]}
  od = __builtin_amdgcn_mfma_f32_32x32x16_bf16(pa0, PK(l0, h0), od, 0, 0, 0);
  od = __builtin_amdgcn_mfma_f32_32x32x16_bf16(pa1, PK(l1, h1), od, 0, 0, 0);
  od = __builtin_amdgcn_mfma_f32_32x32x16_bf16(pa2, PK(l2, h2), od, 0, 0, 0);
  od = __builtin_amdgcn_mfma_f32_32x32x16_bf16(pa3, PK(l3, h3), od, 0, 0, 0);
#undef PK
}
__device__ __forceinline__ void pv_d0(f32x16* o, int vb, bf16x8 pa0, bf16x8 pa1, bf16x8 pa2, bf16x8 pa3) {
  pv_one<0>(o[0], vb, pa0, pa1, pa2, pa3); pv_one<1>(o[1], vb, pa0, pa1, pa2, pa3); pv_one<2>(o[2], vb, pa0, pa1, pa2, pa3); pv_one<3>(o[3], vb, pa0, pa1, pa2, pa3);
}

template <typename TQ>
__device__ __forceinline__ void attn_dense_body(const TQ* Qb, const bf16* __restrict__ Kh, const bf16* __restrict__ Vh,
                                                bf16* Ob, int seq, char* lds, bool do_store = true, const float* qgain = nullptr, int npos0 = 0) {
  using St = Stage<bf16>; using SQ = Stage<TQ>;
  const int tid = ltid(), wid = tid >> 6, lane = tid & 63, r32 = lane & 31, hi = lane >> 5;
  bf16* V_lds = (bf16*)lds; bf16* K_lds = (bf16*)(lds + 2 * SHM_V);
  float* ws = (float*)(lds + 2 * SHM_V + 2 * SHM_K) + wid * 64; float* li_l = ws; float* al_l = ws + 32;
  float m_reg = -1e30f, l_reg = 0; f32x16 o[4] = {}; bf16x8 qr[8];
  const TQ* Qw = Qb + (long)(wid * QBLK + r32) * LDQ + hi * 8;
#pragma unroll
  for (int d0 = 0; d0 < 8; ++d0) qr[d0] = SQ::tobf(SQ::ld8(Qw + d0 * 16));
  if (qgain) {
    float y[8][8]; float ss = 0.f;
#pragma unroll
    for (int d0 = 0; d0 < 8; ++d0)
#pragma unroll
      for (int e = 0; e < 8; ++e) { const float v = __uint_as_float(((unsigned)(unsigned short)qr[d0][e]) << 16); y[d0][e] = v; ss += v * v; }
    ss += __shfl_xor(ss, 32);
    const float rs = __builtin_amdgcn_rsqf(ss * (1.0f / 128.0f) + 1e-6f);
#pragma unroll
    for (int d0 = 0; d0 < 8; ++d0) { const float4 g0 = *(const float4*)(qgain + d0 * 16 + hi * 8), g1 = *(const float4*)(qgain + d0 * 16 + hi * 8 + 4);
      y[d0][0] *= rs * g0.x; y[d0][1] *= rs * g0.y; y[d0][2] *= rs * g0.z; y[d0][3] *= rs * g0.w; y[d0][4] *= rs * g1.x; y[d0][5] *= rs * g1.y; y[d0][6] *= rs * g1.z; y[d0][7] *= rs * g1.w; }
    const int n = npos0 + wid * QBLK + r32;
#pragma unroll
    for (int ax = 0; ax < 2; ++ax) { const float pos = (float)(ax == 0 ? (n >> 6) : (n & 63));
#pragma unroll
      for (int jb = 0; jb < 2; ++jb)
#pragma unroll
        for (int e = 0; e < 8; ++e) { const int j = 16 * jb + 8 * hi + e;
          const float rev = pos * (__builtin_amdgcn_exp2f(-(float)j * (13.287712379549449f / 32.0f)) * 0.15915494309189535f), fr = rev - floorf(rev);
          const float sn = __builtin_amdgcn_sinf(fr), cs = __builtin_amdgcn_cosf(fr);
          const int dA = 4 * ax + jb, dB = dA + 2;
          const float x1 = y[dA][e], x2 = y[dB][e];
          y[dA][e] = x1 * cs - x2 * sn; y[dB][e] = x2 * cs + x1 * sn; } }
#pragma unroll
    for (int d0 = 0; d0 < 8; ++d0) { u32x4 w = {cvtpk(y[d0][0], y[d0][1]), cvtpk(y[d0][2], y[d0][3]), cvtpk(y[d0][4], y[d0][5]), cvtpk(y[d0][6], y[d0][7])}; qr[d0] = *reinterpret_cast<bf16x8*>(&w); }
  }
  const int sr = tid >> 4, sc = (tid & 15) * 8, vst0 = v_st(sr, sc), vst1 = v_st(32 + sr, sc);
  const int vb0 = (int)(uintptr_t)V_lds + v_rd_base(lane);
  struct { typename St::T vs0, vs1, ks0, ks1; } sr_[SDEPTH];
#define SLOAD(i, k0) do { sr_[i].vs0 = St::ld8(&Vh[(long)((k0) + sr) * LDK + sc]); sr_[i].vs1 = St::ld8(&Vh[(long)((k0) + 32 + sr) * LDK + sc]); \
    sr_[i].ks0 = St::ld8(&Kh[(long)((k0) + sr) * LDK + sc]); sr_[i].ks1 = St::ld8(&Kh[(long)((k0) + 32 + sr) * LDK + sc]); } while (0)
#define SWRITE(b, i) do { *(bf16x8*)((char*)V_lds + (b) * SHM_V + vst0) = St::tobf(sr_[i].vs0);          \
    *(bf16x8*)((char*)V_lds + (b) * SHM_V + vst1) = St::tobf(sr_[i].vs1); int kc = sc * 2;               \
    *(bf16x8*)((char*)K_lds + (b) * SHM_K + KSWZ(sr, kc)) = St::tobf(sr_[i].ks0);                       \
    *(bf16x8*)((char*)K_lds + (b) * SHM_K + KSWZ(32 + sr, kc)) = St::tobf(sr_[i].ks1); } while (0)
#define SWAIT() do { if constexpr (SDEPTH == 2) asm volatile("s_waitcnt vmcnt(4)" ::: "memory"); else asm volatile("s_waitcnt vmcnt(0)" ::: "memory"); } while (0)
#define RESC(a) do { if (__any((a) < 1.f)) { if (hi == 0) al_l[r32] = (a); asm volatile("s_waitcnt lgkmcnt(0)" ::: "memory"); \
    for (int d = 0; d < 4; ++d) for (int r = 0; r < 16; ++r) o[d][r] *= al_l[crow(r, hi)]; } } while (0)
  f32x16 pA0, pA1, pB0, pB1; float mnA, mnB, alA, alB; bf16x8 pa0, pa1, pa2, pa3; const int NT = seq / KVBLK;
  constexpr int SE = 0, SO = SDEPTH - 1;
  SLOAD(SE, 0); asm volatile("s_waitcnt vmcnt(0)" ::: "memory"); SWRITE(0, SE); __syncthreads();
  qkt(pA0, pA1, K_lds, qr, r32, hi); partialSM(pA0, pA1, m_reg, mnA, alA);
  SLOAD(SO, KVBLK); if constexpr (SDEPTH == 2) { if (2 < NT) SLOAD(SE, 2 * KVBLK); }
  SWAIT(); SWRITE(1, SO); __syncthreads();
  for (int j = 1; j + 1 < NT; j += 2) {
    SBAR(); qkt(pB0, pB1, (bf16*)((char*)K_lds + SHM_K), qr, r32, hi);
    finishSM(pA0, pA1, alA, l_reg, pa0, pa1, pa2, pa3); SBAR();
    SLOAD(SO, (j + SDEPTH) * KVBLK); SBAR();
    pv_d0(o, vb0, pa0, pa1, pa2, pa3); partialSM(pB0, pB1, m_reg, mnB, alB);
    __syncthreads(); SWAIT(); SWRITE(0, SE);
    RESC(alB); __syncthreads();
    SBAR(); qkt(pA0, pA1, K_lds, qr, r32, hi);
    finishSM(pB0, pB1, alB, l_reg, pa0, pa1, pa2, pa3); SBAR();
    if (SDEPTH == 1 || j + 3 < NT) SLOAD(SE, (j + 1 + SDEPTH) * KVBLK); SBAR();
    pv_d0(o, vb0 + (int)SHM_V, pa0, pa1, pa2, pa3); partialSM(pA0, pA1, m_reg, mnA, alA);
    __syncthreads(); SWAIT(); SWRITE(1, SO);
    RESC(alA); __syncthreads();
  }
  SBAR(); qkt(pB0, pB1, (bf16*)((char*)K_lds + SHM_K), qr, r32, hi);
  finishSM(pA0, pA1, alA, l_reg, pa0, pa1, pa2, pa3); SBAR();
  pv_d0(o, vb0, pa0, pa1, pa2, pa3); partialSM(pB0, pB1, m_reg, mnB, alB);
  __syncthreads(); RESC(alB);
  finishSM(pB0, pB1, alB, l_reg, pa0, pa1, pa2, pa3); SBAR();
  pv_d0(o, vb0 + (int)SHM_V, pa0, pa1, pa2, pa3);
  if (hi == 0) li_l[r32] = l_reg; asm volatile("s_waitcnt lgkmcnt(0)" ::: "memory");
  float rli[16];
#pragma unroll
  for (int r = 0; r < 16; ++r) rli[r] = __builtin_amdgcn_rcpf(li_l[crow(r, hi)]);
  bf16* Ow = Ob + (long)(wid * QBLK) * LDO;
#pragma unroll
  for (int r = 0; r < 16; ++r) { int orow = crow(r, hi); if (!do_store) continue;
    for (int d0 = 0; d0 < 4; ++d0) Ow[(long)orow * LDO + d0 * 32 + r32] = __float2bfloat16(o[d0][r] * rli[r]); }
#undef SLOAD
#undef SWRITE
#undef SWAIT
#undef RESC
}
}
typedef short bf16x8 __attribute__((ext_vector_type(8)));
typedef float f32x4 __attribute__((ext_vector_type(4)));
typedef float f32x16 __attribute__((ext_vector_type(16)));
typedef unsigned u32x4 __attribute__((ext_vector_type(4)));
typedef unsigned u32x2 __attribute__((ext_vector_type(2)));
constexpr size_t MiB = 1ull << 20;
constexpr int MALL = 32768, MG = 16384;
constexpr size_t OFF_WIN = 0, OFF_WBA = 13 * MiB, OFF_WDN = 14 * MiB, OFF_WAT = 16 * MiB, OFF_WO = 18 * MiB, OFF_WUP = 20 * MiB, OFF_WDA = 28 * MiB, OFF_WDB = 32 * MiB,
                 OFF_WPG = 36 * MiB, OFF_WPLE = 38 * MiB, OFF_U = 39 * MiB, OFF_MERGED = 103 * MiB, OFF_ATK = 135 * MiB, OFF_ATV = 143 * MiB, OFF_QN = 167 * MiB,
                 OFF_KN = 183 * MiB, OFF_KT = 199 * MiB, OFF_VF = 215 * MiB, OFF_BETA = 247 * MiB, OFF_G = 249 * MiB, OFF_AUX = 251 * MiB, OFF_CTR = 255 * MiB,
                 OFF_HM = 103 * MiB, OFF_PE = 231 * MiB, OFF_GBUF = 103 * MiB;
constexpr size_t OO_SLOT = 0, OO_ATQ = 64 * MiB, OO_SZ = 96 * MiB, OO_BUFA = 0, OO_BUFB = 32 * MiB;
constexpr int LDS_BYTES = 136 * 1024 + 64;
constexpr int NPHASE = 21;

struct Params { const float* in[21]; float* out; unsigned char* ws; int ph_lo, ph_hi; };

__device__ __forceinline__ float bf2f(u16 b) { return __uint_as_float(((unsigned)b) << 16); }
__device__ __forceinline__ u16 f2bf(float f) { unsigned u = __float_as_uint(f); u += 0x7FFFu + ((u >> 16) & 1u); return (u16)(u >> 16); }
typedef __bf16 bf16x2_t __attribute__((ext_vector_type(2)));
typedef float f32x2_t __attribute__((ext_vector_type(2)));
__device__ __forceinline__ unsigned pk2(float lo, float hi) { f32x2_t f = {lo, hi}; bf16x2_t b = __builtin_convertvector(f, bf16x2_t); return __builtin_bit_cast(unsigned, b); }
__device__ __forceinline__ float sigm(float x) { return __builtin_amdgcn_rcpf(1.0f + __builtin_amdgcn_exp2f(x * -1.4426950408889634f)); }
__device__ __forceinline__ int swap23(int j) { return (j & ~0xC) | ((j & 4) << 1) | ((j & 8) >> 1); }
__device__ __forceinline__ int crow(int r, int hi) { return (r & 3) + 8 * (r >> 2) + 4 * hi; }
__device__ __forceinline__ bf16x8 pack8(const f32x16& v, int base) {
    u32x4 w = {pk2(v[base], v[base + 1]), pk2(v[base + 2], v[base + 3]), pk2(v[base + 4], v[base + 5]), pk2(v[base + 6], v[base + 7])};
    return *reinterpret_cast<bf16x8*>(&w);
}
#define MFMA32(a, b, c) __builtin_amdgcn_mfma_f32_32x32x16_bf16(a, b, c, 0, 0, 0)

enum { E_IN = 0, E_SIG, E_MULRMW, E_MERGE, E_RELU2, E_RES, E_ACC, E_SIG4, E_PLE };
struct GEpi {
    static constexpr bool AFTER_DRAIN = false;
    int mode, perm, ld, pad; u16 *o1, *o2, *o3, *o4, *o5; float* C; const float *r0, *r1;
    __device__ __forceinline__ void operator()(const pg8::f32x4 (&acc)[2][2][4][2], const pg8::Unit& u, int wr, int wc, int fr, int fq) const {
        using namespace pg8;
        const int row0 = u.pm * BM + wr * 64 + fr;
        if (perm) {
            u16* base = o1; u16* dst = o1; int ldd = ld; int colt = u.pn * BM; bool act = false;
            if (mode == E_IN) {
                if (u.pn < 8) { base = o1; ldd = 2048; colt = u.pn * 256; }
                else if (u.pn < 12) { base = o2; ldd = 1024; colt = (u.pn - 8) * 256; }
                else if (u.pn == 12) { base = o3; ldd = 256; colt = 0; }
                else if (u.pn == 13) { base = o4; ldd = 256; colt = 0; }
                else { base = o5; ldd = 1024; colt = (u.pn - 14) * 256; act = true; }
                dst = base;
            }
            if (mode == E_MERGE) dst = o3;
            const int col0 = colt + wc * 32 + 8 * fq;
#pragma unroll
            for (int ai = 0; ai < 2; ++ai)
#pragma unroll
                for (int m = 0; m < 4; ++m) {
                    const size_t roff = (size_t)(row0 + ai * HALF + m * 16) * ldd + col0;
#pragma unroll
                    for (int bj = 0; bj < 2; ++bj) {
                        f32x4 v0 = acc[ai][bj][m][0], v1 = acc[ai][bj][m][1];
                        float v[8] = {v0[0], v0[1], v0[2], v0[3], v1[0], v1[1], v1[2], v1[3]};
                        if (mode == E_IN) { if (act) {
#pragma unroll
                            for (int j = 0; j < 8; ++j) v[j] = v[j] * sigm(v[j]); } }
                        else if (mode == E_SIG) {
#pragma unroll
                            for (int j = 0; j < 8; ++j) v[j] = sigm(v[j]); }
                        else if (mode == E_RELU2) {
#pragma unroll
                            for (int j = 0; j < 8; ++j) { float t = fmaxf(v[j], 0.f); v[j] = t * t; } }
                        else if (mode == E_MULRMW) {
                            const u32x4 g = *(const u32x4*)(o1 + roff + bj * HALF);
#pragma unroll
                            for (int j = 0; j < 4; ++j) { v[2 * j] *= __uint_as_float(g[j] << 16); v[2 * j + 1] *= __uint_as_float(g[j] & 0xffff0000u); } }
                        else {
                            const u32x4 a = *(const u32x4*)(o1 + roff + bj * HALF); const u32x4 g = *(const u32x4*)(o2 + roff + bj * HALF);
#pragma unroll
                            for (int j = 0; j < 4; ++j) { v[2 * j] = __uint_as_float(a[j] << 16) + v[2 * j] * __uint_as_float(g[j] << 16);
                                v[2 * j + 1] = __uint_as_float(a[j] & 0xffff0000u) + v[2 * j + 1] * __uint_as_float(g[j] & 0xffff0000u); } }
#if DBG & 1
                        if (mode == E_MERGE) {
#pragma unroll
                            for (int j = 0; j < 8; ++j) v[j] = 0.f; }
#endif
#if DBG & 2
                        if (mode == E_MULRMW) {
#pragma unroll
                            for (int j = 0; j < 8; ++j) v[j] = 0.f; }
#endif
                        u32x4 w; w.x = pk2(v[0], v[1]); w.y = pk2(v[2], v[3]); w.z = pk2(v[4], v[5]); w.w = pk2(v[6], v[7]);
                        *(u32x4*)(dst + roff + bj * HALF) = w;
                    }
                    asm volatile("" ::: "memory");
                }
        } else {
            const int col0 = u.pn * BM + wc * 32 + 4 * fq;
#pragma unroll
            for (int ai = 0; ai < 2; ++ai)
#pragma unroll
                for (int m = 0; m < 4; ++m) {
                    const int row = row0 + ai * HALF + m * 16;
                    const size_t roff = (size_t)row * ld + col0;
                    const float* rp = (row < MG) ? (r0 + (size_t)row * ld) : (r1 + (size_t)(row - MG) * ld);
#pragma unroll
                    for (int bj = 0; bj < 2; ++bj)
#pragma unroll
                        for (int n = 0; n < 2; ++n) {
                            const size_t off = roff + bj * HALF + n * 16; f32x4 a = acc[ai][bj][m][n];
                            if (mode == E_RES) { const f32x4 x = *(const f32x4*)(rp + col0 + bj * HALF + n * 16); *(f32x4*)(C + off) = x + a; }
                            else if (mode == E_ACC) { const f32x4 x = *(const f32x4*)(C + off); *(f32x4*)(C + off) = x + a; }
                            else if (mode == E_SIG4) { u32x2 w; w.x = pk2(sigm(a[0]), sigm(a[1])); w.y = pk2(sigm(a[2]), sigm(a[3])); *(u32x2*)(o1 + off) = w; }
                            else { const u32x2 g = *(const u32x2*)(o1 + off); const f32x4 x = *(const f32x4*)(C + off);
                                f32x4 o; o[0] = x[0] + __uint_as_float(g.x << 16) * a[0]; o[1] = x[1] + __uint_as_float(g.x & 0xffff0000u) * a[1];
                                o[2] = x[2] + __uint_as_float(g.y << 16) * a[2]; o[3] = x[3] + __uint_as_float(g.y & 0xffff0000u) * a[3]; *(f32x4*)(C + off) = o; }
                        }
                    asm volatile("" ::: "memory");
                }
        }
    }
};
struct GDesc { const u16* A; const u16* Bt; int M, N, K; GEpi e; };
__device__ __forceinline__ bool get_desc(const Params& p, int ph, int k, GDesc& d) {
    unsigned char* ws = p.ws; unsigned char* O = (unsigned char*)p.out;
    d.e = GEpi{}; d.e.perm = 1; d.e.ld = 1024; d.M = MALL; d.N = 1024; d.K = 1024;
    if (ph >= 1 && ph <= 12) {
        const int g = (ph - 1) / 6, sp = (ph - 1) % 6;
        const u16* ug = (const u16*)(ws + OFF_U) + (size_t)g * MG * 1024;
        d.M = MG;
        if (sp == 0) { if (k > 0) return false;
            d.A = ug; d.Bt = (const u16*)(ws + OFF_WIN); d.N = 4608; d.e.mode = E_IN;
            d.e.o1 = (u16*)(O + OO_SLOT); d.e.o2 = (u16*)(O + OO_ATQ); d.e.o3 = (u16*)(ws + OFF_ATK); d.e.o4 = (u16*)(ws + OFF_ATV); d.e.o5 = (u16*)(O + OO_SZ); return true; }
        if (sp != 5 || k > 3) return false;
        u16* bufA = (u16*)(O + OO_BUFA); u16* bufB = (u16*)(O + OO_BUFB); u16* merged = (u16*)(ws + OFF_MERGED) + (size_t)g * MG * 1024;
        if (k == 0) { d.A = ug; d.Bt = (const u16*)(ws + OFF_WIN) + (size_t)4608 * 1024; d.e.mode = E_SIG; d.e.o1 = bufA; }
        else if (k == 1) { d.A = (const u16*)(O + OO_SZ); d.Bt = (const u16*)(ws + OFF_WDN); d.e.mode = E_MULRMW; d.e.o1 = bufA; }
        else if (k == 2) { d.A = ug; d.Bt = (const u16*)(ws + OFF_WIN) + (size_t)5632 * 1024; d.e.mode = E_SIG; d.e.o1 = bufB; }
        else { d.A = (const u16*)(O + OO_ATQ); d.Bt = (const u16*)(ws + OFF_WAT); d.e.mode = E_MERGE; d.e.o1 = bufA; d.e.o2 = bufB; d.e.o3 = merged; }
        return true;
    }
    if (ph == 13) { if (k > 0) return false; d.A = (const u16*)(ws + OFF_MERGED); d.Bt = (const u16*)(ws + OFF_WO); d.e.mode = E_RES; d.e.perm = 0; d.e.C = p.out; d.e.r0 = p.in[0]; d.e.r1 = p.in[1]; return true; }
    if (ph == 15 || ph == 17) { if (k > 1) return false; d.A = (const u16*)(ws + OFF_U); d.Bt = (const u16*)(ws + OFF_WUP) + (ph == 17 ? (size_t)2048 * 1024 : 0) + (size_t)k * 1024 * 1024; d.N = 1024; d.e.mode = E_RELU2; d.e.o1 = (u16*)(ws + OFF_HM) + k * 1024; d.e.ld = 2048; return true; }
    if (ph == 16 || ph == 18) { if (k > 0) return false; d.A = (const u16*)(ws + OFF_HM); d.Bt = (const u16*)(ws + (ph == 16 ? OFF_WDA : OFF_WDB)); d.K = 2048; d.e.mode = E_ACC; d.e.perm = 0; d.e.C = p.out; return true; }
    if (ph == 20) { if (k > 1) return false;
        if (k == 0) { d.A = (const u16*)(ws + OFF_U); d.Bt = (const u16*)(ws + OFF_WPG); d.e.mode = E_SIG4; d.e.perm = 0; d.e.o1 = (u16*)(ws + OFF_GBUF); }
        else { d.A = (const u16*)(ws + OFF_PE); d.Bt = (const u16*)(ws + OFF_WPLE); d.K = 256; d.e.mode = E_PLE; d.e.perm = 0; d.e.o1 = (u16*)(ws + OFF_GBUF); d.e.C = p.out; }
        return true; }
    return false;
}

__device__ __forceinline__ void tconv_unit(const float* __restrict__ src, int ld, int col0, int ncols, int K, u16* __restrict__ dst, int unit, float* tile) {
    const int nK = K / 64, kt = unit % nK, nt2 = unit / nK, k0 = kt * 64, n0 = nt2 * 128, tid = ltid(), a = tid & 63, b = tid >> 6;
    const int a4 = tid & 31, kk = tid >> 5, nl = 4 * a4, hh = nl >> 6, al = nl & 63;
#pragma unroll
    for (int i = 0; i < 4; ++i) { const int k = kk + 16 * i, n = n0 + nl;
        f32x4 v = {0.f, 0.f, 0.f, 0.f};
        if (n < ncols) v = *(const f32x4*)(src + (size_t)(k0 + k) * ld + col0 + n);
        float* tp = tile + hh * 4160 + k * 65 + al; tp[0] = v[0]; tp[1] = v[1]; tp[2] = v[2]; tp[3] = v[3]; }
    __syncthreads();
#pragma unroll
    for (int h = 0; h < 2; ++h)
#pragma unroll
        for (int i = 0; i < 8; ++i) { const int nn = b + 8 * i; if (n0 + 64 * h + nn < ncols) dst[(size_t)(n0 + 64 * h + nn) * K + k0 + a] = f2bf(tile[h * 4160 + a * 65 + nn]); }
    __syncthreads();
}
__device__ void phase_tconv(const Params& p, float* tile) {
    u16* ws = (u16*)p.ws;
    constexpr int NJ = 13;
    const int cum[NJ + 1] = {0, 256, 448, 576, 832, 848, 976, 1104, 1232, 1744, 2000, 2256, 2384, 2416};
    for (int uu = blockIdx.x; uu < 2416; uu += gridDim.x) {
        int j = 0;
#pragma unroll
        for (int q = 1; q < NJ; ++q) if (uu >= cum[q]) j = q;
        const int unit = uu - cum[j];
        const float* src; int ld, col0, ncols, K; size_t doff;
        switch (j) {
            case 0: src = p.in[5]; ld = 6688; col0 = 0; ncols = 2048; K = 1024; doff = OFF_WIN; break;
            case 1: src = p.in[5]; ld = 6688; col0 = 3104; ncols = 1536; K = 1024; doff = OFF_WIN + (size_t)2048 * 2048; break;
            case 2: src = p.in[5]; ld = 6688; col0 = 2048; ncols = 1024; K = 1024; doff = OFF_WIN + (size_t)3584 * 2048; break;
            case 3: src = p.in[5]; ld = 6688; col0 = 4640; ncols = 2048; K = 1024; doff = OFF_WIN + (size_t)4608 * 2048; break;
            case 4: src = p.in[5]; ld = 6688; col0 = 3072; ncols = 32; K = 1024; doff = OFF_WBA; break;
            case 5: src = p.in[10]; ld = 1024; col0 = 0; ncols = 1024; K = 1024; doff = OFF_WDN; break;
            case 6: src = p.in[13]; ld = 1024; col0 = 0; ncols = 1024; K = 1024; doff = OFF_WAT; break;
            case 7: src = p.in[14]; ld = 1024; col0 = 0; ncols = 1024; K = 1024; doff = OFF_WO; break;
            case 8: src = p.in[16]; ld = 4096; col0 = 0; ncols = 4096; K = 1024; doff = OFF_WUP; break;
            case 9: src = p.in[17]; ld = 1024; col0 = 0; ncols = 1024; K = 2048; doff = OFF_WDA; break;
            case 10: src = p.in[17] + (size_t)2048 * 1024; ld = 1024; col0 = 0; ncols = 1024; K = 2048; doff = OFF_WDB; break;
            case 11: src = p.in[19]; ld = 1024; col0 = 0; ncols = 1024; K = 1024; doff = OFF_WPG; break;
            default: src = p.in[20]; ld = 1024; col0 = 0; ncols = 1024; K = 256; doff = OFF_WPLE; break;
        }
        tconv_unit(src, ld, col0, ncols, K, (u16*)(p.ws + doff), unit, tile);
    }
    (void)ws;
}
__device__ void phase_rmsnorm(const float* x0, const float* x1, const float* gain, u16* dst) {
    const int lane = ltid() & 63, gw = blockIdx.x * 8 + __builtin_amdgcn_readfirstlane(ltid() >> 6), nw = gridDim.x * 8;
    f32x4 g4[4];
#pragma unroll
    for (int i = 0; i < 4; ++i) g4[i] = *(const f32x4*)(gain + (i >> 1) * 512 + lane * 8 + (i & 1) * 4);
    f32x4 nx[4];
    { const float* xr = (gw < MG) ? x0 + (size_t)gw * 1024 : x1 + (size_t)(gw - MG) * 1024;
#pragma unroll
      for (int i = 0; i < 4; ++i) nx[i] = *(const f32x4*)(xr + (i >> 1) * 512 + lane * 8 + (i & 1) * 4); }
    for (int r = gw; r < MALL; r += nw) {
        f32x4 v[4]; float ss = 0.f;
#pragma unroll
        for (int i = 0; i < 4; ++i) v[i] = nx[i];
        const int rn = r + nw;
        if (rn < MALL) { const float* xr = (rn < MG) ? x0 + (size_t)rn * 1024 : x1 + (size_t)(rn - MG) * 1024;
#pragma unroll
            for (int i = 0; i < 4; ++i) nx[i] = *(const f32x4*)(xr + (i >> 1) * 512 + lane * 8 + (i & 1) * 4); }
#pragma unroll
        for (int i = 0; i < 4; ++i) ss += v[i][0] * v[i][0] + v[i][1] * v[i][1] + v[i][2] * v[i][2] + v[i][3] * v[i][3];
#pragma unroll
        for (int o = 32; o >= 1; o >>= 1) ss += __shfl_xor(ss, o);
        const float rs = rsqrtf(ss * (1.0f / 1024.0f) + 1e-6f);
        u16* d = dst + (size_t)r * 1024;
#pragma unroll
        for (int c = 0; c < 2; ++c) { const f32x4 a = v[2 * c], bq = v[2 * c + 1], ga = g4[2 * c], gb = g4[2 * c + 1];
            u32x4 w; w.x = pk2(a[0] * rs * ga[0], a[1] * rs * ga[1]); w.y = pk2(a[2] * rs * ga[2], a[3] * rs * ga[3]);
            w.z = pk2(bq[0] * rs * gb[0], bq[1] * rs * gb[1]); w.w = pk2(bq[2] * rs * gb[2], bq[3] * rs * gb[3]);
            *(u32x4*)(d + c * 512 + lane * 8) = w; }
    }
}
__device__ void phase_pe_cvt(const float* p0, const float* p1, u16* dst) {
    const size_t n8 = (size_t)MALL * 256 / 8, half = (size_t)MG * 256 / 8;
    for (size_t i = (size_t)blockIdx.x * 512 + ltid(); i < n8; i += (size_t)gridDim.x * 512) {
        const float* s = (i < half) ? p0 + i * 8 : p1 + (i - half) * 8;
        const f32x4 a = *(const f32x4*)s, b = *(const f32x4*)(s + 4);
        u32x4 w; w.x = pk2(a[0], a[1]); w.y = pk2(a[2], a[3]); w.z = pk2(b[0], b[1]); w.w = pk2(b[2], b[3]);
        *(u32x4*)(dst + i * 8) = w;
    }
}

__device__ void conv_unit(const Params& p, int g, int wu, int lane) {
    const int Ng = g ? 2048 : 8192;
    const int quarter = wu & 3, tb = wu >> 2, t0 = tb * 32, n0 = t0 % Ng;
    const u16* raw = (const u16*)((unsigned char*)p.out + OO_SLOT);
    const int cq = quarter * 512 + lane * 8;
    const float* cw = p.in[6];
    float w[5][8];
#pragma unroll
    for (int j = 0; j < 5; ++j) { const f32x4 a = *(const f32x4*)(cw + j * 2048 + cq), b = *(const f32x4*)(cw + j * 2048 + cq + 4);
        w[j][0] = a[0]; w[j][1] = a[1]; w[j][2] = a[2]; w[j][3] = a[3]; w[j][4] = b[0]; w[j][5] = b[1]; w[j][6] = b[2]; w[j][7] = b[3]; }
    u32x4 xr[5];
#pragma unroll
    for (int j = 0; j < 4; ++j) {
        const int n = n0 + j - 2; xr[j] = (u32x4){0u, 0u, 0u, 0u};
        if (n >= 0 && n < Ng) xr[j] = *(const u32x4*)(raw + (size_t)(t0 + j - 2) * 2048 + cq);
    }
    u16* qn = (u16*)(p.ws + OFF_QN); u16* kn = (u16*)(p.ws + OFF_KN); u16* kT = (u16*)(p.ws + OFF_KT); u16* vf = (u16*)(p.ws + OFF_VF);
    unsigned ybp[8][8];
#pragma unroll 1
    for (int h16 = 0; h16 < 2; ++h16) {
#pragma unroll
        for (int q4 = 0; q4 < 4; ++q4) {
            const int i4 = h16 * 4 + q4;
            float ylo[8];
            u32x4 vcu[4];
#pragma unroll
            for (int k4 = 0; k4 < 4; ++k4) { const int i = 4 * i4 + k4; const int n = n0 + i + 2; vcu[k4] = (u32x4){0u, 0u, 0u, 0u}; if (n < Ng) vcu[k4] = *(const u32x4*)(raw + (size_t)(t0 + i + 2) * 2048 + cq); }
#pragma unroll
            for (int k4 = 0; k4 < 4; ++k4) {
                const int i = 4 * i4 + k4;
                xr[4] = vcu[k4];
                float y[8]; float ss = 0.f;
#pragma unroll
                for (int e = 0; e < 8; ++e) { float sm = 0.f;
#pragma unroll
                    for (int j = 0; j < 5; ++j) { const unsigned wd = xr[j][e >> 1]; sm += w[j][e] * __uint_as_float((e & 1) ? (wd & 0xffff0000u) : (wd << 16)); }
                    sm = sm * sigm(sm); y[e] = sm; ss += sm * sm; }
#pragma unroll
                for (int j = 0; j < 4; ++j) xr[j] = xr[j + 1];
                const int t = t0 + i;
                if (quarter < 2) {
                    ss += __shfl_xor(ss, 1); ss += __shfl_xor(ss, 2); ss += __shfl_xor(ss, 4); ss += __shfl_xor(ss, 8);
                    float rs = rsqrtf(ss + 1e-6f); if (quarter == 0) rs *= 0.088388347648318440f;
#pragma unroll
                    for (int e = 0; e < 8; ++e) y[e] *= rs;
                    const int head = lane >> 4, d0 = (lane & 15) * 8, g16 = d0 >> 4, odd = lane & 1;
                    u16* dstp = (quarter == 0 ? qn : kn) + (size_t)t * 512 + head * 128 + g16 * 16 + odd * 4;
                    u32x2 lo, hi2; lo.x = pk2(y[0], y[1]); lo.y = pk2(y[2], y[3]); hi2.x = pk2(y[4], y[5]); hi2.y = pk2(y[6], y[7]);
                    *(u32x2*)dstp = lo; *(u32x2*)(dstp + 8) = hi2;
                }
#pragma unroll
                for (int e = 0; e < 8; ++e) { if ((k4 & 1) == 0) ylo[e] = y[e]; else ybp[2 * q4 + (k4 >> 1)][e] = pk2(ylo[e], y[e]); }
            }
        }
        const int tq = t0 + 16 * h16, chunk = tq >> 6, c0 = tq & 63;
        if (quarter == 1) {
            const int head = lane >> 4, d0 = (lane & 15) * 8;
            u16* kt = kT + ((size_t)(chunk * 4 + head) * 128 + d0) * 64 + c0;
#pragma unroll
            for (int e = 0; e < 8; ++e) {
                u32x4 w0, w1;
                w0.x = ybp[0][e]; w0.y = ybp[1][e];
                w0.z = ybp[4][e]; w0.w = ybp[5][e];
                w1.x = ybp[2][e]; w1.y = ybp[3][e];
                w1.z = ybp[6][e]; w1.w = ybp[7][e];
                *(u32x4*)(kt + e * 64) = w0; *(u32x4*)(kt + e * 64 + 8) = w1; }
        } else if (quarter >= 2) {
            const int vhead = (quarter - 2) * 4 + (lane >> 4), dv = (lane & 15) * 8, sl = dv >> 5, j0 = dv & 31;
            const int tt = c0 >> 5, rb = ((c0 >> 4) & 1) * 8;
            u16* vp = vf + ((size_t)((chunk * 8 + vhead) * 4 + sl)) * 2048 + tt * 1024 + j0 * 16 + rb;
#pragma unroll
            for (int e = 0; e < 8; ++e) {
                u32x4 w0, w1;
                w0.x = ybp[0][e]; w0.y = ybp[1][e];
                w0.z = ybp[4][e]; w0.w = ybp[5][e];
                w1.x = ybp[2][e]; w1.y = ybp[3][e];
                w1.z = ybp[6][e]; w1.w = ybp[7][e];
                *(u32x4*)(vp + e * 16) = w0; *(u32x4*)(vp + e * 16 + 32 * 16) = w1; }
        }
    }
}
__device__ void normrope_rows(u16* base, int nrows, int hshift  , const float* gain, int Ng, int gw, int nw, int lane) {
    const int i16 = lane & 15, sub = lane >> 4;
    float gn[8];
    { const f32x4 a = *(const f32x4*)(gain + i16 * 8), b = *(const f32x4*)(gain + i16 * 8 + 4); gn[0] = a[0]; gn[1] = a[1]; gn[2] = a[2]; gn[3] = a[3]; gn[4] = b[0]; gn[5] = b[1]; gn[6] = b[2]; gn[7] = b[3]; }
    const int ax = i16 >> 3, sgn = (i16 >> 2) & 1;
    float inv[8];
#pragma unroll
    for (int e = 0; e < 8; ++e) { const int j = (i16 & 3) * 8 + e; inv[e] = exp2f(-(float)j * (13.287712379549449f / 32.0f)) * 0.15915494309189535f; }
    u32x4 nv = {0u, 0u, 0u, 0u};
    if (gw < nrows / 4) nv = *(const u32x4*)(base + (size_t)(gw * 4 + sub) * 128 + i16 * 8);
    for (int r4 = gw; r4 < nrows / 4; r4 += nw) {
        const int row = r4 * 4 + sub; const int t = row >> hshift; const int n = t % Ng;
        const float pos = (float)(ax == 0 ? (n >> 6) : (n & 63));
        u16* rp = base + (size_t)row * 128 + i16 * 8;
        const u32x4 v = nv; float y[8]; float ss = 0.f;
        if (r4 + nw < nrows / 4) nv = *(const u32x4*)(base + (size_t)((r4 + nw) * 4 + sub) * 128 + i16 * 8);
#pragma unroll
        for (int e = 0; e < 4; ++e) { y[2 * e] = __uint_as_float(v[e] << 16); y[2 * e + 1] = __uint_as_float(v[e] & 0xffff0000u); }
#pragma unroll
        for (int e = 0; e < 8; ++e) ss += y[e] * y[e];
        ss += __shfl_xor(ss, 1); ss += __shfl_xor(ss, 2); ss += __shfl_xor(ss, 4); ss += __shfl_xor(ss, 8);
        const float rs = rsqrtf(ss * (1.0f / 128.0f) + 1e-6f);
        float o[8];
#pragma unroll
        for (int e = 0; e < 8; ++e) { y[e] = y[e] * rs * gn[e]; }
#pragma unroll
        for (int e = 0; e < 8; ++e) { const float pr = __shfl_xor(y[e], 4); const float rev = pos * inv[e]; const float fr = rev - floorf(rev);
            const float sn = __builtin_amdgcn_sinf(fr), cs = __builtin_amdgcn_cosf(fr);
            o[e] = y[e] * cs + (sgn ? pr : -pr) * sn; }
        u32x4 w; w.x = pk2(o[0], o[1]); w.y = pk2(o[2], o[3]); w.z = pk2(o[4], o[5]); w.w = pk2(o[6], o[7]);
        *(u32x4*)rp = w;
    }
}
__device__ void ba_task(const Params& p, int g, int task, int lane) {
    const int r32 = lane & 31, hi = lane >> 5;
    const u16* u = (const u16*)(p.ws + OFF_U) + (size_t)(g * MG + task * 32 + r32) * 1024 + 8 * hi;
    const u16* wb = (const u16*)(p.ws + OFF_WBA) + (size_t)r32 * 1024 + 8 * hi;
    f32x16 acc = {};
#pragma unroll 8
    for (int ks = 0; ks < 64; ++ks) { const bf16x8 a = *(const bf16x8*)(u + ks * 16), b = *(const bf16x8*)(wb + ks * 16); acc = MFMA32(a, b, acc); }
    float* beta = (float*)(p.ws + OFF_BETA); float* gg = (float*)(p.ws + OFF_G);
    const int n = r32; const bool isb = n < 16; const int nn = n & 15;
    const float al = isb ? 0.f : -__expf(p.in[7][nn]), db = isb ? 0.f : p.in[8][nn];
#pragma unroll
    for (int r = 0; r < 16; ++r) { const int tok = g * MG + task * 32 + crow(r, hi); const float v = acc[r];
        if (isb) beta[(size_t)tok * 16 + nn] = sigm(v);
        else { const float z = v + db; const float sp = fmaxf(z, 0.f) + log1pf(__expf(-fabsf(z))); gg[(size_t)tok * 16 + nn] = al * sp; } }
}
__device__ void phase_g2(const Params& p, int g) {
    const int lane = ltid() & 63, gw = blockIdx.x * 8 + __builtin_amdgcn_readfirstlane(ltid() >> 6), nw = gridDim.x * 8;
    const int Ng = g ? 2048 : 8192;
    for (int wu = gw; wu < 2048; wu += nw) conv_unit(p, g, wu, lane);
#if defined(G2X)
    for (int wu = gw; wu < 2048; wu += nw) conv_unit(p, g, wu, lane);
#endif
    normrope_rows((u16*)(p.ws + OFF_ATK), MG * 2, 1, p.in[12], Ng, gw, nw, lane);
}

#define WBAR() do { asm volatile("s_waitcnt lgkmcnt(0)" ::: "memory"); __builtin_amdgcn_wave_barrier(); asm volatile("" ::: "memory"); } while (0)
template <int dir> __device__ __forceinline__ void prep_item(const Params& p, int g, int item, int lane0, float* sA  ) {
    int lane = lane0; asm volatile("" : "+v"(lane));
    const int h = (item >> 1) & 7, cgk = item >> 4, hq = h >> 1;
    const int r32 = lane & 31, hi = lane >> 5;
    float* sg = sA + 4096; float* sb = sg + 64;
    u16* st16 = (u16*)sA;
    const int tokg = g * MG + cgk * 64 + lane;
    const float bet = ((const float*)(p.ws + OFF_BETA))[(size_t)tokg * 16 + dir * 8 + h];
    const float gv = ((const float*)(p.ws + OFF_G))[(size_t)tokg * 16 + dir * 8 + h];
    float gc = gv;
#pragma unroll
    for (int o = 1; o < 64; o <<= 1) {
        const int src = dir == 0 ? lane - o : lane + o;
        const float t = __int_as_float(__builtin_amdgcn_ds_bpermute((src & 63) << 2, __float_as_int(gc)));
        if (dir == 0 ? (lane >= o) : (lane + o < 64)) gc += t;
    }
    const float gl = __int_as_float(__builtin_amdgcn_readlane(__float_as_int(gc), dir == 0 ? 63 : 0));
    float* aux = (float*)(p.ws + OFF_AUX);
    aux[(size_t)item * 64 + lane] = __expf(gc);
    aux[(size_t)(MiB / 4) + (size_t)item * 64 + lane] = bet;
    aux[(size_t)(2 * MiB / 4) + (size_t)item * 64 + lane] = __expf(gl - gc);
    if (lane == 0) aux[(size_t)(3 * MiB / 4) + item] = __expf(gl);
    sg[lane] = gc; sb[lane] = bet;
    const u16* kn = (const u16*)(p.ws + OFF_KN) + (size_t)(cgk * 64 + r32) * 512 + hq * 128 + 8 * hi;
    const u16* qn = (const u16*)(p.ws + OFF_QN) + (size_t)(cgk * 64 + r32) * 512 + hq * 128 + 8 * hi;
    u32x4* slot = (u32x4*)((unsigned char*)p.out + OO_SLOT + (size_t)item * 16384);
    WBAR();
    bf16x8 kf[2][8];
#pragma unroll
    for (int ks = 0; ks < 8; ++ks) { kf[0][ks] = *(const bf16x8*)(kn + ks * 16); kf[1][ks] = *(const bf16x8*)(kn + 32 * 512 + ks * 16); }
    {
        bf16x8 qf[2][8];
#pragma unroll
        for (int ks = 0; ks < 8; ++ks) { qf[0][ks] = *(const bf16x8*)(qn + ks * 16); qf[1][ks] = *(const bf16x8*)(qn + 32 * 512 + ks * 16); }
        f32x16 QK[2][2] = {};
#pragma unroll
        for (int ks = 0; ks < 8; ++ks) {
            QK[0][0] = MFMA32(qf[0][ks], kf[0][ks], QK[0][0]); if (dir != 0) QK[0][1] = MFMA32(qf[0][ks], kf[1][ks], QK[0][1]); if (dir == 0) QK[1][0] = MFMA32(qf[1][ks], kf[0][ks], QK[1][0]); QK[1][1] = MFMA32(qf[1][ks], kf[1][ks], QK[1][1]);
        }
#pragma unroll
        for (int ti = 0; ti < 2; ++ti)
#pragma unroll
            for (int tj = 0; tj < 2; ++tj) {
                const int j = 32 * tj + r32; const float gj = sg[j];
                const bool ztile = (dir == 0) ? (ti == 0 && tj == 1) : (ti == 1 && tj == 0);
#pragma unroll
                for (int r = 0; r < 16; ++r) {
                    const int i = 32 * ti + crow(r, hi); const float gi = sg[i];
                    if (ztile) { st16[i * 64 + swap23(j)] = (u16)0; continue; }
                    const float dec = __expf(fminf(gi - gj, 0.f));
                    const float mk = fminf(fmaxf((float)(dir == 0 ? i - j : j - i) + 1.0f, 0.f), 1.f);
                    st16[i * 64 + swap23(j)] = f2bf(QK[ti][tj][r] * dec * mk);
                    if ((r & 3) == 3) asm volatile("" ::: "memory");
                }
            }
    }
    WBAR();
#pragma unroll
    for (int it = 0; it < 8; ++it) slot[512 + it * 64 + lane] = ((const u32x4*)st16)[it * 64 + lane];
    WBAR();
    {
        f32x16 KK[2][2] = {};
#pragma unroll
        for (int ks = 0; ks < 8; ++ks) {
            KK[0][0] = MFMA32(kf[0][ks], kf[0][ks], KK[0][0]); if (dir != 0) KK[0][1] = MFMA32(kf[0][ks], kf[1][ks], KK[0][1]); if (dir == 0) KK[1][0] = MFMA32(kf[1][ks], kf[0][ks], KK[1][0]); KK[1][1] = MFMA32(kf[1][ks], kf[1][ks], KK[1][1]);
        }
#pragma unroll
        for (int ti = 0; ti < 2; ++ti)
#pragma unroll
            for (int tj = 0; tj < 2; ++tj) {
                const int j = 32 * tj + r32; const float gj = sg[j];
#pragma unroll
                for (int r = 0; r < 16; ++r) {
                    const int i = 32 * ti + crow(r, hi); const float gi = sg[i], bi = sb[i];
                    const int ii = dir ? 63 - i : i, jj = dir ? 63 - j : j;
                    if ((dir == 0) ? (ti == 0 && tj == 1) : (ti == 1 && tj == 0)) { sA[ii * 64 + jj] = 0.f; continue; }
                    const float dec = __expf(fminf(gi - gj, 0.f));
                    const float mk = fminf(fmaxf((float)(dir == 0 ? i - j : j - i), 0.f), 1.f);
                    sA[ii * 64 + jj] = bi * KK[ti][tj][r] * dec * mk;
                    if ((r & 3) == 3) asm volatile("" ::: "memory");
                }
            }
    }
    WBAR();
    const float fl = (float)lane;
#pragma unroll 1
    for (int gi = 0; gi < 16; ++gi) {
        const int i0 = 4 * gi;
        const float d0 = fl - (float)i0;
        float acc0 = fmaxf(1.0f - fabsf(d0), 0.f), acc1 = fmaxf(1.0f - fabsf(d0 - 1.0f), 0.f), acc2 = fmaxf(1.0f - fabsf(d0 - 2.0f), 0.f), acc3 = fmaxf(1.0f - fabsf(d0 - 3.0f), 0.f);
        const float* ar = sA + i0 * 64;
#pragma unroll 4
        for (int j4 = 0; j4 < gi; ++j4) {
            const float* xr = sA + (4 * j4) * 64 + lane;
            const float x0 = xr[0], x1 = xr[64], x2 = xr[128], x3 = xr[192];
            const f32x4 a0 = *(const f32x4*)(ar + 4 * j4), a1 = *(const f32x4*)(ar + 64 + 4 * j4), a2 = *(const f32x4*)(ar + 128 + 4 * j4), a3 = *(const f32x4*)(ar + 192 + 4 * j4);
            acc0 -= a0[0] * x0; acc0 -= a0[1] * x1; acc0 -= a0[2] * x2; acc0 -= a0[3] * x3;
            acc1 -= a1[0] * x0; acc1 -= a1[1] * x1; acc1 -= a1[2] * x2; acc1 -= a1[3] * x3;
            acc2 -= a2[0] * x0; acc2 -= a2[1] * x1; acc2 -= a2[2] * x2; acc2 -= a2[3] * x3;
            acc3 -= a3[0] * x0; acc3 -= a3[1] * x1; acc3 -= a3[2] * x2; acc3 -= a3[3] * x3;
        }
        const f32x4 t1 = *(const f32x4*)(ar + 64 + i0), t2 = *(const f32x4*)(ar + 128 + i0), t3 = *(const f32x4*)(ar + 192 + i0);
        const float y0 = acc0;
        const float y1 = acc1 - t1[0] * y0;
        const float y2 = acc2 - t2[0] * y0 - t2[1] * y1;
        const float y3 = acc3 - t3[0] * y0 - t3[1] * y1 - t3[2] * y2;
        WBAR();
        sA[(i0 + 0) * 64 + lane] = y0; sA[(i0 + 1) * 64 + lane] = y1; sA[(i0 + 2) * 64 + lane] = y2; sA[(i0 + 3) * 64 + lane] = y3;
        WBAR();
    }
    {
        u16* so = (u16*)slot;
        const int cc = swap23(dir ? 63 - lane : lane);
#pragma unroll 4
        for (int i = 0; i < 64; ++i) { const int ii = dir ? 63 - i : i; so[ii * 64 + cc] = f2bf(sA[i * 64 + lane]); }
    }
    WBAR();
}
__device__ void phase_g3(const Params& p, int g, float* lds) {
    const int lane = ltid() & 63, wv = __builtin_amdgcn_readfirstlane(ltid() >> 6), gw = blockIdx.x * 8 + wv, nw = gridDim.x * 8;
    float* sA = lds + wv * (4096 + 128);
    for (int item0 = gw; item0 < 4096; item0 += nw) { const int item = __builtin_amdgcn_readfirstlane(item0); if (item & 1) prep_item<1>(p, g, item, lane, sA); else prep_item<0>(p, g, item, lane, sA); }
}

#define LAS3 __attribute__((address_space(3)))
__device__ __forceinline__ bf16x8 lds_frag(unsigned char* lds, int byteoff) { return *(const LAS3 bf16x8*)((LAS3 unsigned char*)lds + byteoff); }
__device__ void scan_item(const Params& p, int g, int it, unsigned char* lds, bool do_store = true) {
    const int Ng = g ? 2048 : 8192, nc = Ng / 64;
    const int b = __builtin_amdgcn_readfirstlane(it >> 3), h = __builtin_amdgcn_readfirstlane(it & 7), hq = h >> 1;
    const int tid = ltid(), lane = tid & 63, wv = __builtin_amdgcn_readfirstlane(tid >> 6), dir = wv >> 2, s = wv & 3, r32 = lane & 31, hi = lane >> 5;
    const u16* kn = (const u16*)(p.ws + OFF_KN); const u16* qn = (const u16*)(p.ws + OFF_QN); const u16* kT = (const u16*)(p.ws + OFF_KT);
    const u16* vfb = (const u16*)(p.ws + OFF_VF);
    const float* aux = (const float*)(p.ws + OFF_AUX);
    u16* slots = (u16*)((unsigned char*)p.out + OO_SLOT);
    const int dbase = dir * 65536;
#define STAGE_X(st) do { _Pragma("unroll") for (int i = 0; i < 8; ++i) { const int d = i >> 2, tile = (i >> 1) & 1; \
        const int ci_ = d ? nc - 1 - (st) : (st), cg_ = b * nc + ci_; const int row = ((i & 1) * 8 + wv) * 4 + (lane >> 4), cc = (lane & 15) ^ (row & 15); \
        const u16* src = (tile ? qn : kn) + (size_t)(cg_ * 64 + row) * 512 + hq * 128 + cc * 8; \
        __builtin_amdgcn_global_load_lds((const unsigned*)src, (LAS3 unsigned*)((LAS3 unsigned char*)lds + d * 65536 + tile * 16384 + ((i & 1) * 8 + wv) * 1024), 16, 0, 0); } } while (0)
#define STAGE_Y(st) do { _Pragma("unroll") for (int i = 0; i < 8; ++i) { const int d = i >> 2, q5 = (i & 3) * 8 + wv; \
        const int ci_ = d ? nc - 1 - (st) : (st), cg_ = b * nc + ci_; const int item_ = ((cg_ * 8 + h) << 1) + d; \
        const int u = (q5 & 15) * 64 + lane, row = (q5 < 16) ? (u >> 3) : ((u & 511) >> 3), cc = (u & 7) ^ ((row >> 1) & 7); \
        const u16* src = (q5 < 16) ? kT + ((size_t)(cg_ * 4 + hq) * 128 + row) * 64 + cc * 8 : slots + (size_t)item_ * 8192 + (q5 < 24 ? 0 : 4096) + row * 64 + cc * 8; \
        __builtin_amdgcn_global_load_lds((const unsigned*)src, (LAS3 unsigned*)((LAS3 unsigned char*)lds + d * 65536 + 32768 + q5 * 1024), 16, 0, 0); } \
        if (s == 0) { const int ci_ = dir ? nc - 1 - (st) : (st), item_ = (((b * nc + ci_) * 8 + h) << 1) + dir; const int l48 = lane < 48 ? lane : 47; \
            const float* src = aux + (size_t)(l48 >> 4) * (MiB / 4) + (size_t)item_ * 64 + (l48 & 15) * 4; \
            __builtin_amdgcn_global_load_lds((const unsigned*)src, (LAS3 unsigned*)((LAS3 unsigned char*)lds + 131072 + dir * 1024), 16, 0, 0); } } while (0)
    f32x16 S[4] = {};
    STAGE_X(0); STAGE_Y(0);
    asm volatile("s_waitcnt vmcnt(0)" ::: "memory"); __syncthreads();
    for (int step = 0; step < nc; ++step) {
        const int ci = dir ? nc - 1 - step : step, cgk = b * nc + ci, item = ((cgk * 8 + h) << 1) + dir;
        u16* slot = slots + (size_t)item * 8192;
        bf16x8 Sb[4][2];
#pragma unroll
        for (int m = 0; m < 4; ++m) { Sb[m][0] = pack8(S[m], 0); Sb[m][1] = pack8(S[m], 8); }
        f32x16 P[2] = {}, Q[2] = {};
#pragma unroll
        for (int t = 0; t < 2; ++t)
#pragma unroll
            for (int m = 0; m < 4; ++m)
#pragma unroll
                for (int sp = 0; sp < 2; ++sp) {
                    const int row = 32 * t + r32, c = 4 * m + 2 * sp + hi, off = dbase + (row * 16 + (c ^ (row & 15))) * 16;
                    const bf16x8 ka = lds_frag(lds, off), qa = lds_frag(lds, off + 16384);
                    P[t] = MFMA32(ka, Sb[m][sp], P[t]); Q[t] = MFMA32(qa, Sb[m][sp], Q[t]);
                }
        const float egl = aux[(size_t)(3 * MiB / 4) + item];
        const u16* vp = vfb + ((size_t)((cgk * 8 + h) * 4 + s)) * 2048 + lane * 16;
        const u32x4 v00 = *(const u32x4*)(vp), v01 = *(const u32x4*)(vp + 8), v10 = *(const u32x4*)(vp + 1024), v11 = *(const u32x4*)(vp + 1032);
        asm volatile("s_waitcnt vmcnt(0) lgkmcnt(0)" ::: "memory"); __syncthreads();
        if (step + 1 < nc) STAGE_X(step + 1);
        const int abase = 131072 + dir * 1024 + 16 * hi;
        bf16x8 Rb[2][2];
#pragma unroll
        for (int t = 0; t < 2; ++t) {
            const u32x4 v0 = t ? v10 : v00, v1 = t ? v11 : v01;
            float vv[16];
#pragma unroll
            for (int e = 0; e < 4; ++e) { vv[2 * e] = __uint_as_float(v0[e] << 16); vv[2 * e + 1] = __uint_as_float(v0[e] & 0xffff0000u);
                vv[8 + 2 * e] = __uint_as_float(v1[e] << 16); vv[8 + 2 * e + 1] = __uint_as_float(v1[e] & 0xffff0000u); }
#pragma unroll
            for (int q = 0; q < 4; ++q) { const f32x4 eg = *(const LAS3 f32x4*)((LAS3 unsigned char*)lds + abase + (32 * t + 8 * q) * 4);
                const f32x4 bt = *(const LAS3 f32x4*)((LAS3 unsigned char*)lds + abase + 256 + (32 * t + 8 * q) * 4);
#pragma unroll
                for (int e = 0; e < 4; ++e) { const int r = 4 * q + e; P[t][r] = bt[e] * (vv[r] - eg[e] * P[t][r]); } }
            Rb[t][0] = pack8(P[t], 0); Rb[t][1] = pack8(P[t], 8);
        }
        f32x16 Vn[2] = {};
#pragma unroll
        for (int ti = 0; ti < 2; ++ti)
#pragma unroll
            for (int t = 0; t < 2; ++t)
#pragma unroll
                for (int sp = 0; sp < 2; ++sp) { const int row = 32 * ti + r32, c = 4 * t + 2 * sp + hi;
                    const bf16x8 ta = lds_frag(lds, dbase + 49152 + (row * 8 + (c ^ ((row >> 1) & 7))) * 16); Vn[ti] = MFMA32(ta, Rb[t][sp], Vn[ti]); }
        bf16x8 Vb[2][2];
#pragma unroll
        for (int t = 0; t < 2; ++t) { Vb[t][0] = pack8(Vn[t], 0); Vb[t][1] = pack8(Vn[t], 8); }
#pragma unroll
        for (int ti = 0; ti < 2; ++ti) {
#pragma unroll
            for (int q = 0; q < 4; ++q) { const f32x4 eg = *(const LAS3 f32x4*)((LAS3 unsigned char*)lds + abase + (32 * ti + 8 * q) * 4);
#pragma unroll
                for (int e = 0; e < 4; ++e) Q[ti][4 * q + e] *= eg[e]; }
#pragma unroll
            for (int t = 0; t < 2; ++t)
#pragma unroll
                for (int sp = 0; sp < 2; ++sp) { const int row = 32 * ti + r32, c = 4 * t + 2 * sp + hi;
                    const bf16x8 aa = lds_frag(lds, dbase + 57344 + (row * 8 + (c ^ ((row >> 1) & 7))) * 16); Q[ti] = MFMA32(aa, Vb[t][sp], Q[ti]); }
        }
#pragma unroll
        for (int t = 0; t < 2; ++t) {
#pragma unroll
            for (int q = 0; q < 4; ++q) { const f32x4 ek = *(const LAS3 f32x4*)((LAS3 unsigned char*)lds + abase + 512 + (32 * t + 8 * q) * 4);
#pragma unroll
                for (int e = 0; e < 4; ++e) Vn[t][4 * q + e] *= ek[e]; }
            Vb[t][0] = pack8(Vn[t], 0); Vb[t][1] = pack8(Vn[t], 8);
        }
#pragma unroll
        for (int m = 0; m < 4; ++m) {
#pragma unroll
            for (int r = 0; r < 16; ++r) S[m][r] *= egl;
#pragma unroll
            for (int t = 0; t < 2; ++t)
#pragma unroll
                for (int sp = 0; sp < 2; ++sp) { const int row = 32 * m + r32, c = 4 * t + 2 * sp + hi;
                    const bf16x8 ka = lds_frag(lds, dbase + 32768 + (row * 8 + (c ^ ((row >> 1) & 7))) * 16); S[m] = MFMA32(ka, Vb[t][sp], S[m]); }
        }
        asm volatile("s_waitcnt vmcnt(0) lgkmcnt(0)" ::: "memory"); __syncthreads();
#pragma unroll
        for (int ti = 0; ti < 2; ++ti)
#pragma unroll
            for (int r = 0; r < 16; ++r) if (do_store) slot[(size_t)(32 * ti + crow(r, hi)) * 128 + s * 32 + r32] = f2bf(Q[ti][r]);
        if (step + 1 < nc) STAGE_Y(step + 1);
    }
    asm volatile("s_waitcnt vmcnt(0)" ::: "memory"); __syncthreads();
#undef STAGE_X
#undef STAGE_Y
}
__device__ void phase_g4(const Params& p, int g, unsigned char* lds) {
    const int Ng = g ? 2048 : 8192, Bg = g ? 8 : 2, nscan = Bg * 8, nqb = Ng / 256, natt = Bg * 8 * nqb, total = nscan + natt;
    unsigned* ctr = (unsigned*)(p.ws + OFF_CTR) + g * 64;
    volatile int* sitem = (volatile int*)(lds + 136 * 1024);
    att::bf16* atq = (att::bf16*)((unsigned char*)p.out + OO_ATQ);
    const att::bf16* atk = (const att::bf16*)(p.ws + OFF_ATK); const att::bf16* atv = (const att::bf16*)(p.ws + OFF_ATV);
    for (;;) {
        if (ltid() == 0) *sitem = (int)atomicAdd(ctr, 1u);
        __syncthreads();
        const int it = *sitem;
        __syncthreads();
        if (it >= total) break;
        if (it < nscan) {
#if (G4T & 1) && !(DBG & 512)
#if defined(SCANX)
            scan_item(p, g, it, lds, false);
#endif
            scan_item(p, g, it, lds);
#endif
        } else {
#if G4T & 2
            const int a = it - nscan, qb = a % nqb, h = (a / nqb) & 7, b = a / (nqb * 8);
            const size_t tok = (size_t)b * Ng + (size_t)qb * 256;
            att::bf16* Qb = atq + tok * 1024 + h * 128;
            const size_t kvo = (size_t)b * Ng * 256 + (h >> 2) * 128;
#if DBG & 256
            { u16* q16 = (u16*)Qb; for (int e = ltid(); e < 256 * 16; e += 512) { const int r = e >> 4, c8 = (e & 15) * 8; *(u32x4*)(q16 + (size_t)r * 1024 + c8) = (u32x4){0u, 0u, 0u, 0u}; } }
#elif !(DBG & 128)
#if defined(ATTX)
            att::attn_dense_body<att::bf16>(Qb, atk + kvo, atv + kvo, Qb, Ng, (char*)lds, false);
            __syncthreads();
#endif
            att::attn_dense_body<att::bf16>(Qb, atk + kvo, atv + kvo, Qb, Ng, (char*)lds, true, p.in[11], qb * 256);
#endif
            __syncthreads();
#endif
        }
    }
}

__device__ void phase_g5(const Params& p, int g) {
    const int lane = ltid() & 63, gw = blockIdx.x * 8 + __builtin_amdgcn_readfirstlane(ltid() >> 6), nw = gridDim.x * 8, i16 = lane & 15, sub = lane >> 4;
    const u16* slots = (const u16*)((unsigned char*)p.out + OO_SLOT); u16* sz = (u16*)((unsigned char*)p.out + OO_SZ);
    float gn[8];
    { const f32x4 a = *(const f32x4*)(p.in[9] + i16 * 8), b = *(const f32x4*)(p.in[9] + i16 * 8 + 4); gn[0] = a[0]; gn[1] = a[1]; gn[2] = a[2]; gn[3] = a[3]; gn[4] = b[0]; gn[5] = b[1]; gn[6] = b[2]; gn[7] = b[3]; }
    u32x4 na = {0u, 0u, 0u, 0u}, nb = na, nz = na;
#define G5_ADDR(R4) const int row_ = (R4) * 4 + sub, t_ = row_ >> 3, h_ = row_ & 7, cgk_ = t_ >> 6, c_ = t_ & 63; \
        const u16* of_ = slots + ((size_t)((cgk_ * 8 + h_) << 1)) * 8192 + c_ * 128 + i16 * 8; u16* zp_ = sz + (size_t)t_ * 1024 + h_ * 128 + i16 * 8;
    if (gw < MG * 8 / 4) { G5_ADDR(gw) na = *(const u32x4*)of_; nb = *(const u32x4*)(of_ + 8192); nz = *(const u32x4*)zp_; }
    for (int r4 = gw; r4 < MG * 8 / 4; r4 += nw) {
        const int row = r4 * 4 + sub, t = row >> 3, h = row & 7;
        u16* zp = sz + (size_t)t * 1024 + h * 128 + i16 * 8;
        const u32x4 a = na, b = nb, z = nz;
        if (r4 + nw < MG * 8 / 4) { G5_ADDR(r4 + nw) na = *(const u32x4*)of_; nb = *(const u32x4*)(of_ + 8192); nz = *(const u32x4*)zp_; }
        float y[8]; float ss = 0.f;
#pragma unroll
        for (int e = 0; e < 4; ++e) { y[2 * e] = __uint_as_float(a[e] << 16) + __uint_as_float(b[e] << 16); y[2 * e + 1] = __uint_as_float(a[e] & 0xffff0000u) + __uint_as_float(b[e] & 0xffff0000u); }
#pragma unroll
        for (int e = 0; e < 8; ++e) ss += y[e] * y[e];
        ss += __shfl_xor(ss, 1); ss += __shfl_xor(ss, 2); ss += __shfl_xor(ss, 4); ss += __shfl_xor(ss, 8);
        const float rs = rsqrtf(ss * (1.0f / 128.0f) + 1e-6f);
        float o[8];
#pragma unroll
        for (int e = 0; e < 4; ++e) { o[2 * e] = y[2 * e] * rs * gn[2 * e] * __uint_as_float(z[e] << 16); o[2 * e + 1] = y[2 * e + 1] * rs * gn[2 * e + 1] * __uint_as_float(z[e] & 0xffff0000u); }
        u32x4 w; w.x = pk2(o[0], o[1]); w.y = pk2(o[2], o[3]); w.z = pk2(o[4], o[5]); w.w = pk2(o[6], o[7]);
        *(u32x4*)zp = w;
    }
}

#define XB_TMO      128
#define XB_XCNT(j)  (256  + 64 * (j))
#define XB_XSUB(j)  (1280 + 64 * (j))
#define XB_XGEN(j)  (2304 + 64 * (j))
#define XB_TOP      3328
#define XB_TOPGEN   3392
#define XCD_BAR_WORDS 3456
#define XB_SPIN_CAP (1u << 18)
#define LAS __attribute__((address_space(3)))

__device__ __forceinline__ unsigned xb_ld(unsigned* p)              { return __hip_atomic_load(p, __ATOMIC_RELAXED, __HIP_MEMORY_SCOPE_AGENT); }
__device__ __forceinline__ unsigned xb_add(unsigned* p, unsigned v) { return __hip_atomic_fetch_add(p, v, __ATOMIC_RELAXED, __HIP_MEMORY_SCOPE_AGENT); }
__device__ __forceinline__ unsigned xb_xcc_id() { return (unsigned)__builtin_amdgcn_s_getreg((3 << 11) | 20) & 0xFu; }
#define XB_SPIN(cond, bar) do { unsigned _sp = 0; while (cond) { __builtin_amdgcn_s_sleep(1); \
    if ((++_sp & 255u) == 0u) { if (xb_ld(&(bar)[XB_TMO])) break; if (_sp > XB_SPIN_CAP) { atomicAdd(&(bar)[XB_TMO], 1u); break; } } } } while (0)

struct XcdBarrier {
    unsigned* bar; unsigned x;
    volatile LAS unsigned* st;
};

__device__ __forceinline__ XcdBarrier xcd_barrier_post(unsigned* bar, volatile LAS unsigned* st) {
    XcdBarrier b; b.bar = bar; b.x = xb_xcc_id(); b.st = st;
    if (ltid() == 0) (void)xb_add(&bar[XB_XCNT(b.x)], 1u);
    return b;
}
__device__ __forceinline__ void xcd_barrier_complete(unsigned* bar, unsigned x, unsigned& nloc, unsigned& nx) {
    const unsigned G = gridDim.x * gridDim.y * gridDim.z;
    unsigned sum, cnt, mine, sp = 0u;
    for (;;) {
        sum = 0u; cnt = 0u; mine = 0u;
#pragma unroll
        for (unsigned j = 0; j < 16; ++j) { const unsigned c = xb_ld(&bar[XB_XCNT(j)]); sum += c; cnt += (c > 0u) ? 1u : 0u; mine = (j == x) ? c : mine; }
        if (sum == G) break;
        __builtin_amdgcn_s_sleep(1);
        if ((++sp & 255u) == 0u) { if (xb_ld(&bar[XB_TMO])) break; if (sp > XB_SPIN_CAP) { atomicAdd(&bar[XB_TMO], 1u); break; } }
    }
    nloc = mine > 0u ? mine : 1u; nx = cnt > 0u ? cnt : 1u;
}

__device__ __forceinline__ void xcd_barrier(const XcdBarrier& b) {
    asm volatile("s_waitcnt vmcnt(0)" ::: "memory");
    __syncthreads();
    if (ltid() == 0) {
        unsigned* bar = b.bar;
        __builtin_amdgcn_s_waitcnt(0);
        unsigned nloc = b.st[0], nx = b.st[1];
        if (nloc == 0u) { xcd_barrier_complete(bar, b.x, nloc, nx); b.st[0] = nloc; b.st[1] = nx; }
        const unsigned old = xb_add(&bar[XB_XSUB(b.x)], 1u);
        const unsigned gen = old / nloc;
        if (old + 1u == (gen + 1u) * nloc) {
            __builtin_amdgcn_fence(__ATOMIC_RELEASE, "agent");
            asm volatile("s_waitcnt vmcnt(0)" ::: "memory");
            const unsigned og = xb_add(&bar[XB_TOP], 1u);
            const unsigned tg = og / nx;
            if (og + 1u == (tg + 1u) * nx) xb_add(&bar[XB_TOPGEN], 1u);
            else XB_SPIN(xb_ld(&bar[XB_TOPGEN]) == tg, bar);
            __builtin_amdgcn_fence(__ATOMIC_ACQUIRE, "agent");
            xb_add(&bar[XB_XGEN(b.x)], 1u);
            asm volatile("s_waitcnt vmcnt(0)" ::: "memory");
        } else {
            XB_SPIN(xb_ld(&bar[XB_XGEN(b.x)]) == gen, bar);
            __builtin_amdgcn_fence(__ATOMIC_ACQUIRE, "agent");
            asm volatile("s_waitcnt vmcnt(0)" ::: "memory");
        }
    }
    __syncthreads();
}


__global__ void __launch_bounds__(512) mega(Params p) {
    extern __shared__ __attribute__((aligned(16))) unsigned char lds[];
    cg::grid_group grid = cg::this_grid();
    unsigned char* ws = p.ws;
#if defined(RLO)
    int rep_done = 0;
#define RHI2 RHI
#endif
#if defined(RMASK)
    unsigned rep_m = 0;
#endif
#if defined(XSYNC)
    for (int xs = 0; xs < XSYNC; ++xs) grid.sync();
#endif
    volatile LAS unsigned* xst = (volatile LAS unsigned*)((LAS unsigned char*)lds + 136 * 1024 + 16);
    if (ltid() < 2) xst[ltid()] = 0u;
    __syncthreads();
    XcdBarrier xb = xcd_barrier_post((unsigned*)(p.ws + OFF_CTR + 4096), xst);
    for (int ph = p.ph_lo; ph < p.ph_hi; ++ph) {
        if (ph > p.ph_lo) { if (p.ph_hi > 1000) grid.sync(); else xcd_barrier(xb); }
#if DBG & 4
        if (ph >= 19) continue;
#endif
#if DBG & 8
        if (ph >= 14 && ph <= 18) continue;
#endif
        if (ph == 0) {
#if PHM & 1
            phase_tconv(p, (float*)lds);
            phase_rmsnorm(p.in[0], p.in[1], p.in[4], (u16*)(ws + OFF_U));
#endif
        } else if (ph <= 12) {
            const int g = (ph - 1) / 6, sp = (ph - 1) % 6;
            if (sp == 1) {
#if PHM & 4
                phase_g2(p, g);
#endif
            } else if (sp == 2) {
#if PHM & 8
                phase_g3(p, g, (float*)lds);
#endif
            } else if (sp == 3) {
#if PHM & 16
                phase_g4(p, g, lds);
#endif
            } else if (sp == 4) {
#if PHM & 32
                phase_g5(p, g);
#endif
            }
        } else if (ph == 14) {
            phase_rmsnorm(p.out, p.out + (size_t)MG * 1024, p.in[15], (u16*)(ws + OFF_U));
        } else if (ph == 19) {
            phase_rmsnorm(p.out, p.out + (size_t)MG * 1024, p.in[18], (u16*)(ws + OFF_U));
            phase_pe_cvt(p.in[2], p.in[3], (u16*)(ws + OFF_PE));
        }
#if PHM & 2
#pragma unroll 1
        for (int k = 0; k < 4; ++k) {
            GDesc d;
            if (!get_desc(p, ph, k, d)) break;
            pg8::Gemm gm; gm.A = d.A; gm.Bt = d.Bt; gm.M = d.M; gm.N = d.N; gm.K = d.K;
            pg8::StaticOrder S; S.init(d.M, d.N, (int)gridDim.x, (int)blockIdx.x);
            pg8::gemm_phase<GEpi, pg8::StaticOrder, false>((PG8_LAS unsigned char*)lds, gm, S, d.e, nullptr);
            __syncthreads();
        }
        if (ph >= 1 && ph <= 12 && (ph - 1) % 6 == 0) {
            const int half = (int)gridDim.x / 2, gwb = ((int)blockIdx.x - half) * 8 + __builtin_amdgcn_readfirstlane(ltid() >> 6), nwb = ((int)gridDim.x - half) * 8;
            if ((int)blockIdx.x >= half) for (int task = gwb; task < MG / 32; task += nwb) ba_task(p, (ph - 1) / 6, task, ltid() & 63);
        }
#endif
#if defined(RLO)
        if (ph == RHI && !rep_done) { rep_done = 1; ph = RLO - 1; }
        else if (ph == RHI && rep_done && ph != RHI2) rep_done = 0 * 0 + 1;
#endif
#if defined(RMASK)
        if (((RMASK >> ph) & 1) && !(rep_m & (1u << ph))) { rep_m |= 1u << ph; --ph; }
#endif
    }
}

__global__ void dbg_copy(const float* a, const float* b, float* o) { for (size_t i = (size_t)blockIdx.x * 256 + threadIdx.x; i < (size_t)MALL * 1024; i += (size_t)gridDim.x * 256) o[i] = i < (size_t)MG * 1024 ? a[i] : b[i - (size_t)MG * 1024]; }
#ifndef PH_END
#define PH_END NPHASE
#endif
#ifndef ONE_LAUNCH
#define ONE_LAUNCH 1
#endif
extern "C" void kernel_launch(void* const* d_in, const int* in_sizes, int n_in, void* d_out, int out_size, void* d_ws, size_t ws_size, hipStream_t stream) {
    static int grid = 0;
    if (grid == 0) {
        if (n_in != 21 || ws_size < 256 * MiB) { fprintf(stderr, "kernel_launch: unexpected n_in %d / ws %zu\n", n_in, ws_size); grid = -1; return; }
        if (hipFuncSetAttribute((const void*)mega, hipFuncAttributeMaxDynamicSharedMemorySize, LDS_BYTES) != hipSuccess) { fprintf(stderr, "kernel_launch: hipFuncSetAttribute failed\n"); grid = -1; return; }
        int dev = 0, cus = 0, per_cu = 0;
        hipGetDevice(&dev); hipDeviceGetAttribute(&cus, hipDeviceAttributeMultiprocessorCount, dev);
        hipOccupancyMaxActiveBlocksPerMultiprocessor(&per_cu, (const void*)mega, 512, LDS_BYTES);
        if (per_cu < 1) { fprintf(stderr, "kernel_launch: occupancy query says %d blocks/CU\n", per_cu); per_cu = 1; }
        (void)hipGetLastError();
        grid = cus;
    }
    if (grid < 0) return;
    hipMemsetAsync((unsigned char*)d_ws + OFF_CTR, 0, 32768, stream);
#if DBG & 32
    hipLaunchKernelGGL(dbg_copy, dim3(2048), dim3(256), 0, stream, (const float*)d_in[0], (const float*)d_in[1], (float*)d_out); return;
#endif
    Params p{};
    for (int i = 0; i < 21; ++i) p.in[i] = (const float*)d_in[i];
    p.out = (float*)d_out; p.ws = (unsigned char*)d_ws;
#if ONE_LAUNCH
    p.ph_lo = 0; p.ph_hi = NPHASE;
    void* args[] = {&p};
    hipError_t e = hipLaunchCooperativeKernel((const void*)mega, dim3(grid), dim3(512), args, LDS_BYTES, stream);
    if (e != hipSuccess) fprintf(stderr, "cooperative launch failed: %s (grid %d)\n", hipGetErrorString(e), grid);
#else
    for (int ph = 0; ph < PH_END; ++ph) {
#if DBG & 64
        if (ph == 1) hipMemsetAsync((unsigned char*)d_ws + OFF_MERGED, 0, 64 * MiB, stream);
        if (ph >= 1 && ph <= 12) continue;
#endif
        p.ph_lo = ph; p.ph_hi = ph + 1;
        hipLaunchKernelGGL(mega, dim3(grid), dim3(512), LDS_BYTES, stream, p);
    }
    hipError_t e = hipPeekAtLastError();
    if (e != hipSuccess) fprintf(stderr, "launch failed: %s\n", hipGetErrorString(e));
#endif
}
```
